# Optimizing an MI355X kernel written in HIP

```python
import math
import jax, jax.numpy as jnp
from jax import lax
import numpy as np

D_MODEL = 2048
BATCH = 16
SEQ = 2048
DEPTH = 4

GRID_W = 64
CTX_LEN = 256
MIX_W = D_MODEL
DIFF_W = MIX_W // 4
GQA_W = MIX_W // 2
HY_CH = MIX_W - DIFF_W - GQA_W
DIFF_V = 128
DIFF_QK = DIFF_V // 2
DIFF_HEADS = DIFF_W // DIFF_V
GQA_HD = 128
GQA_HEADS = GQA_W // GQA_HD
GQA_KV_HEADS = 2
GQA_GROUP = GQA_HEADS // GQA_KV_HEADS
HY_EMB = 33
HY_BANDS = (HY_EMB - 1) // 2
HY_FFN = 64
HY_FAST_DECAY = 0.3
HY_SLOW_DECAY = 1.5
HY_TARGET = 1e-2
HY_SHIFT = 0.0
SHORT_K = 3
D_FF = 4 * D_MODEL
N_MOD = 6
ROPE_THETA = 10000.0
Q_BLOCK = 128
EPS = 1e-6

DQ_W = DIFF_HEADS * 2 * DIFF_QK
GQ_W = GQA_HEADS * GQA_HD
HY_W = 3 * HY_CH
DK_W = DQ_W
DV_W = DIFF_HEADS * DIFF_V
GK_W = GQA_KV_HEADS * GQA_HD
GV_W = GK_W
KV_OFF = DQ_W + GQ_W + HY_W
KV_W = DK_W + DV_W + GK_W + GV_W
N_IN = KV_OFF + KV_W

kernel_name = "hymba_style_diffattn_gqa_hyena_dit"


def rmsnorm(x, g):
    xf = x.astype(jnp.float32)
    y = xf * lax.rsqrt(jnp.mean(xf * xf, axis=-1, keepdims=True) + EPS)
    return (y * g.astype(jnp.float32)).astype(x.dtype)


def modulate(x, shift, scale):
    return x * (1 + scale) + shift


def axial_rope(n_rows, head_dim):
    t_row = jnp.repeat(jnp.arange(n_rows, dtype=jnp.float32), GRID_W)
    t_col = jnp.tile(jnp.arange(GRID_W, dtype=jnp.float32), n_rows)
    d_axis = head_dim // 2
    inv = ROPE_THETA ** (-jnp.arange(0, d_axis, 2, dtype=jnp.float32) / d_axis)
    ang = jnp.concatenate([t_row[:, None] * inv, t_col[:, None] * inv], axis=-1)
    return jnp.cos(ang), jnp.sin(ang)


def apply_rope(x, cos, sin):
    xf = x.astype(jnp.float32).reshape(*x.shape[:-1], -1, 2)
    x0, x1 = xf[..., 0], xf[..., 1]
    out = jnp.stack([x0 * cos - x1 * sin, x0 * sin + x1 * cos], axis=-1)
    return out.reshape(x.shape).astype(x.dtype)


def heads(t, *dims):
    b, n = t.shape[:2]
    return jnp.moveaxis(t.reshape(b, n, *dims), 1, -2)


def merge(t):
    t = jnp.moveaxis(t, -2, 1)
    return t.reshape(t.shape[0], t.shape[1], -1)


def split_front(h):
    return jnp.split(h, [DQ_W, DQ_W + GQ_W], axis=-1)


def split_kv(h):
    return jnp.split(h, [DK_W, DK_W + DV_W, DK_W + DV_W + GK_W], axis=-1)


def sweep_query_blocks(fn, q):
    n = q.shape[-2]
    nb = n // Q_BLOCK
    qb = jnp.moveaxis(q.reshape(*q.shape[:-2], nb, Q_BLOCK, q.shape[-1]), -3, 0)
    out = jnp.moveaxis(lax.map(fn, qb), 0, -3)
    return out.reshape(*out.shape[:-3], n, out.shape[-1])


def diff_lambda(lam_params, lam_init):
    p = lam_params.astype(jnp.float32)
    return jnp.exp(jnp.sum(p[0] * p[1])) - jnp.exp(jnp.sum(p[2] * p[3])) + lam_init


def diff_attend(q, k, v, lam):
    s = jnp.einsum('bhmqd,bhmkd->bhmqk', q, k).astype(jnp.float32) * (DIFF_QK ** -0.5)
    p = jax.nn.softmax(s, axis=-1)
    a = p[:, :, 0] - lam * p[:, :, 1]
    return jnp.einsum('bhqk,bhkd->bhqd', a.astype(v.dtype), v)


def gqa_attend(q, k, v):
    s = jnp.einsum('bgrqd,bgkd->bgrqk', q, k).astype(jnp.float32) * (GQA_HD ** -0.5)
    p = jax.nn.softmax(s, axis=-1).astype(v.dtype)
    return jnp.einsum('bgrqk,bgkd->bgrqd', p, v)


def hyena_filters(n, w1, b1, w2, b2, w3, b3, wout, freq):
    f32 = jnp.float32
    t = jnp.linspace(0.0, 1.0, n, dtype=f32)[:, None]
    w = 2.0 * math.pi * jnp.arange(n, dtype=f32)[:, None] / n
    f = jnp.linspace(1e-4, HY_BANDS - 1, HY_BANDS, dtype=f32)[None, :]
    z = jnp.concatenate([t, jnp.cos(f * w), -jnp.sin(f * w)], axis=-1)
    fr = freq.astype(f32)
    h = jnp.sin(fr[0] * (z @ w1.astype(f32) + b1.astype(f32)))
    h = jnp.sin(fr[1] * (h @ w2.astype(f32) + b2.astype(f32)))
    h = jnp.sin(fr[2] * (h @ w3.astype(f32) + b3.astype(f32)))
    h = h @ wout.astype(f32)
    min_decay = math.log(HY_TARGET) / HY_SLOW_DECAY
    max_decay = math.log(HY_TARGET) / HY_FAST_DECAY
    deltas = jnp.linspace(min_decay, max_decay, HY_CH, dtype=f32)
    decay = jnp.exp(-t * jnp.abs(deltas))
    return h * (jnp.concatenate([decay, decay], axis=-1) + HY_SHIFT)


def bidir_long_conv(u, h2, bias):
    n, ch = u.shape[1], u.shape[2]
    hf, hb = h2[:, :ch], h2[:, ch:]
    h_full = jnp.concatenate([hf, jnp.zeros((1, ch), hf.dtype), hb[:0:-1]], axis=0)
    uf = u.astype(jnp.float32)
    y = jnp.fft.irfft(jnp.fft.rfft(uf, n=2 * n, axis=1) * jnp.fft.rfft(h_full, n=2 * n, axis=0)[None],
                      n=2 * n, axis=1)[:, :n]
    return (y + uf * bias.astype(jnp.float32)).astype(u.dtype)


def short_conv3(u, w, b):
    up = jnp.pad(u, ((0, 0), (1, 1), (0, 0)))
    return up[:, :-2] * w[0] + up[:, 1:-1] * w[1] + up[:, 2:] * w[2] + b


def hyena_mixer(hy, conv_w, conv_b, filt, bias):
    u = short_conv3(hy, conv_w, conv_b)
    x0, x1, v = jnp.split(u, 3, axis=-1)
    return x0 * bidir_long_conv(v * x1, filt, bias)


def sq_relu_mlp(x, w_up, w_down):
    return jnp.square(jax.nn.relu(x @ w_up)) @ w_down


def setup_inputs(seed: int = 0) -> dict:
    key = jax.random.key(seed)
    ks = jax.random.split(key, 32)

    def nrm(i, shape, scale):
        return jax.random.normal(ks[i], shape, jnp.float32) * scale

    nl = DEPTH
    return {
        "x": nrm(0, (BATCH, SEQ, D_MODEL), 1.0),
        "c": nrm(1, (BATCH, D_MODEL), 1.0),
        "ctx": nrm(2, (BATCH, CTX_LEN, D_MODEL), 1.0),
        "c_ctx": nrm(3, (D_MODEL,), 1.0),
        "w_mod": nrm(4, (nl, D_MODEL, N_MOD * D_MODEL), 0.5 * D_MODEL ** -0.5),
        "b_mod": nrm(5, (nl, N_MOD * D_MODEL), 0.02),
        "g_norm": 1.0 + nrm(6, (nl, 4, D_MODEL), 0.1),
        "w_in": nrm(7, (nl, D_MODEL, N_IN), D_MODEL ** -0.5),
        "w_out": nrm(8, (nl, MIX_W, D_MODEL), MIX_W ** -0.5),
        "diff_lam": nrm(9, (nl, 4, DIFF_QK), 0.1),
        "diff_subln": 1.0 + nrm(10, (nl, DIFF_V), 0.1),
        "gqa_q_norm": 1.0 + nrm(11, (nl, GQA_HD), 0.1),
        "gqa_k_norm": 1.0 + nrm(12, (nl, GQA_HD), 0.1),
        "gqa_out_norm": 1.0 + nrm(13, (nl, GQA_HD), 0.1),
        "hy_conv_w": nrm(14, (nl, SHORT_K, HY_W), SHORT_K ** -0.5),
        "hy_conv_b": nrm(15, (nl, HY_W), 0.02),
        "hy_w1": nrm(16, (nl, HY_EMB, HY_FFN), HY_EMB ** -0.5),
        "hy_b1": nrm(17, (nl, HY_FFN), 0.1),
        "hy_w2": nrm(18, (nl, HY_FFN, HY_FFN), HY_FFN ** -0.5),
        "hy_b2": nrm(19, (nl, HY_FFN), 0.1),
        "hy_w3": nrm(20, (nl, HY_FFN, HY_FFN), HY_FFN ** -0.5),
        "hy_b3": nrm(21, (nl, HY_FFN), 0.1),
        "hy_wout": nrm(22, (nl, HY_FFN, 2 * HY_CH), 0.1 * HY_FFN ** -0.5),
        "hy_freq": 1.0 + nrm(23, (nl, 3, HY_FFN), 0.1),
        "hy_bias": nrm(24, (nl, HY_CH), 0.5),
        "hy_out_norm": 1.0 + nrm(25, (nl, HY_CH), 0.1),
        "w_up": nrm(26, (nl, D_MODEL, D_FF), D_MODEL ** -0.5),
        "w_down": nrm(27, (nl, D_FF, D_MODEL), D_FF ** -0.5),
    }


def reference(x, c, ctx, c_ctx, w_mod, b_mod, g_norm, w_in, w_out, diff_lam, diff_subln,
              gqa_q_norm, gqa_k_norm, gqa_out_norm, hy_conv_w, hy_conv_b, hy_w1, hy_b1,
              hy_w2, hy_b2, hy_w3, hy_b3, hy_wout, hy_freq, hy_bias, hy_out_norm, w_up, w_down):
    n_lat = x.shape[1]
    n_ctx = ctx.shape[1]
    ROWS = n_lat // GRID_W
    cos_d, sin_d = axial_rope(ROWS, DIFF_QK)
    cos_g, sin_g = axial_rope(ROWS, GQA_HD)
    s_c = jax.nn.silu(c)
    s_cc = jax.nn.silu(c_ctx)
    xc = ctx
    for l in range(DEPTH):
        last = l == DEPTH - 1
        lam_init = 0.8 - 0.6 * math.exp(-0.3 * l)
        lam = diff_lambda(diff_lam[l], lam_init)
        sh_a, sc_a, gt_a, sh_m, sc_m, gt_m = jnp.split((s_c @ w_mod[l] + b_mod[l])[:, None, :], N_MOD, axis=-1)
        csh_a, csc_a, cgt_a, csh_m, csc_m, cgt_m = jnp.split(s_cc @ w_mod[l] + b_mod[l], N_MOD, axis=-1)
        filt_args = (hy_w1[l], hy_b1[l], hy_w2[l], hy_b2[l], hy_w3[l], hy_b3[l], hy_wout[l], hy_freq[l])

        xn = modulate(rmsnorm(x, g_norm[l, 0]), sh_a, sc_a)
        xcn = modulate(rmsnorm(xc, g_norm[l, 0]), csh_a, csc_a)
        h = xn @ w_in[l]
        hc = xcn @ (w_in[l][:, KV_OFF:] if last else w_in[l])
        dq, gq, hy = split_front(h[..., :KV_OFF])
        dk, dv, gk, gv = split_kv(h[..., KV_OFF:])
        cdk, cdv, cgk, cgv = split_kv(hc[..., -KV_W:])

        q_d = apply_rope(heads(dq, DIFF_HEADS, 2, DIFF_QK), cos_d, sin_d)
        k_d = apply_rope(heads(dk, DIFF_HEADS, 2, DIFF_QK), cos_d, sin_d)
        kc_d = heads(cdk, DIFF_HEADS, 2, DIFF_QK)
        vc_d = heads(cdv, DIFF_HEADS, DIFF_V)
        kd_all = jnp.concatenate([kc_d, k_d], axis=-2)
        vd_all = jnp.concatenate([vc_d, heads(dv, DIFF_HEADS, DIFF_V)], axis=-2)
        o_d = sweep_query_blocks(lambda qb: diff_attend(qb, kd_all, vd_all, lam), q_d)
        o_d = merge(rmsnorm(o_d, diff_subln[l]) * (1.0 - lam_init))

        q_g = apply_rope(rmsnorm(heads(gq, GQA_KV_HEADS, GQA_GROUP, GQA_HD), gqa_q_norm[l]), cos_g, sin_g)
        k_g = apply_rope(rmsnorm(heads(gk, GQA_KV_HEADS, GQA_HD), gqa_k_norm[l]), cos_g, sin_g)
        kc_g = rmsnorm(heads(cgk, GQA_KV_HEADS, GQA_HD), gqa_k_norm[l])
        vc_g = heads(cgv, GQA_KV_HEADS, GQA_HD)
        kg_all = jnp.concatenate([kc_g, k_g], axis=-2)
        vg_all = jnp.concatenate([vc_g, heads(gv, GQA_KV_HEADS, GQA_HD)], axis=-2)
        o_g = sweep_query_blocks(lambda qb: gqa_attend(qb, kg_all, vg_all), q_g)
        o_g = merge(rmsnorm(o_g, gqa_out_norm[l]))

        filt_lat = hyena_filters(n_lat, *filt_args)
        o_h = rmsnorm(hyena_mixer(hy, hy_conv_w[l], hy_conv_b[l], filt_lat, hy_bias[l]), hy_out_norm[l])

        mix = jnp.concatenate([o_d, o_g, o_h], axis=-1) @ w_out[l]
        x = x + gt_a * rmsnorm(mix, g_norm[l, 1])

        if not last:
            cdq, cgq, chy = split_front(hc[..., :KV_OFF])
            oc_d = diff_attend(heads(cdq, DIFF_HEADS, 2, DIFF_QK), kc_d, vc_d, lam)
            oc_d = merge(rmsnorm(oc_d, diff_subln[l]) * (1.0 - lam_init))
            oc_g = gqa_attend(rmsnorm(heads(cgq, GQA_KV_HEADS, GQA_GROUP, GQA_HD), gqa_q_norm[l]), kc_g, vc_g)
            oc_g = merge(rmsnorm(oc_g, gqa_out_norm[l]))
            filt_ctx = hyena_filters(n_ctx, *filt_args)
            oc_h = rmsnorm(hyena_mixer(chy, hy_conv_w[l], hy_conv_b[l], filt_ctx, hy_bias[l]), hy_out_norm[l])
            mix_c = jnp.concatenate([oc_d, oc_g, oc_h], axis=-1) @ w_out[l]
            xc = xc + cgt_a * rmsnorm(mix_c, g_norm[l, 1])

        xn = modulate(rmsnorm(x, g_norm[l, 2]), sh_m, sc_m)
        x = x + gt_m * rmsnorm(sq_relu_mlp(xn, w_up[l], w_down[l]), g_norm[l, 3])
        if not last:
            xcn = modulate(rmsnorm(xc, g_norm[l, 2]), csh_m, csc_m)
            xc = xc + cgt_m * rmsnorm(sq_relu_mlp(xcn, w_up[l], w_down[l]), g_norm[l, 3])
    return x
```

```cpp
#include <hip/hip_runtime.h>
#include <cstdio>
#include <cstdint>

#ifndef PG8_WGM
#define PG8_WGM 4
#endif
#define GAS __attribute__((address_space(1)))
#define LAS __attribute__((address_space(3)))
#define DI __device__ __forceinline__
typedef unsigned short u16;
typedef short bf16x8 __attribute__((ext_vector_type(8)));
typedef short s16x4 __attribute__((ext_vector_type(4)));
typedef float f32x2 __attribute__((ext_vector_type(2)));
typedef float f32x4 __attribute__((ext_vector_type(4)));
typedef float f32x16 __attribute__((ext_vector_type(16)));
typedef unsigned u32x2 __attribute__((ext_vector_type(2)));
typedef unsigned u32x4 __attribute__((ext_vector_type(4)));
typedef __bf16 bf16x2_t __attribute__((ext_vector_type(2)));

constexpr int DM = 2048, NBATCH = 16, SEQ = 2048, CTXL = 256, RPB = SEQ + CTXL  , NROWS = NBATCH * RPB  ;
constexpr int NLAYER = 4, NIN = 4608, DFF = 8192, NMOD = 6;
constexpr int C_DQ = 0, C_GQ = 512, C_HY = 1536, C_DK = 3072, C_DV = 3584, C_GK = 4096, C_GV = 4352;
constexpr float EPS = 1e-6f;

DI unsigned pk2(float lo, float hi) { f32x2 v = {lo, hi}; bf16x2_t b = __builtin_convertvector(v, bf16x2_t); return __builtin_bit_cast(unsigned, b); }
DI float bflo(unsigned w) { return __uint_as_float(w << 16); }
DI float bfhi(unsigned w) { return __uint_as_float(w & 0xffff0000u); }
DI float bf1(u16 h) { return __uint_as_float(((unsigned)h) << 16); }
DI u16 tobf(float v) { return (u16)(pk2(v, 0.f) & 0xffffu); }
template <int CTRL> DI float dppf(float v) { return __builtin_bit_cast(float, __builtin_amdgcn_update_dpp(0, __builtin_bit_cast(int, v), CTRL, 0xf, 0xf, true)); }
DI float sum_rows16(float v) {
    auto t = __builtin_amdgcn_permlane16_swap(__float_as_uint(v), __float_as_uint(v), false, false); return __uint_as_float(t[0]) + __uint_as_float(t[1]); }
DI float sum_halves32(float v) {
    auto t = __builtin_amdgcn_permlane32_swap(__float_as_uint(v), __float_as_uint(v), false, false); return __uint_as_float(t[0]) + __uint_as_float(t[1]); }
DI float sum8(float v) { v += dppf<0xB1>(v); v += dppf<0x4E>(v); v += dppf<0x141>(v); return v; }
DI float sum16(float v) { v = sum8(v); v += dppf<0x140>(v); return v; }
DI float sum32(float v) { return sum_rows16(sum16(v)); }
DI float wave_sum(float v) { return sum_halves32(sum32(v)); }
DI float frsq(float x) { return __builtin_amdgcn_rsqf(x); }
DI float rdlane(float v, int l) { return __builtin_bit_cast(float, __builtin_amdgcn_readlane(__builtin_bit_cast(int, v), l)); }

extern __shared__ __attribute__((aligned(16))) unsigned char lds_raw[];
constexpr int WTAB_OFF = 139776;
DI int hw_wave_slot() { return (int)__builtin_amdgcn_s_getreg((5 << 11) | 4) & 63; }
DI int lane_id() { int l; asm volatile("v_mbcnt_lo_u32_b32 %0, -1, 0\n\tv_mbcnt_hi_u32_b32 %0, -1, %0" : "=v"(l)); return l; }
DI int ktid() { const unsigned w = ((volatile LAS unsigned*)((LAS unsigned char*)lds_raw + WTAB_OFF))[hw_wave_slot()]; return (int)__builtin_amdgcn_readfirstlane(w) * 64 + lane_id(); }
DI int opaque_tid() { int t = ktid(); asm volatile("" : "+v"(t)); return t; }

namespace pg8 {
#define PG8_LAS __attribute__((address_space(3)))
typedef unsigned short bf16_t;
typedef short bf16x8 __attribute__((ext_vector_type(8)));
typedef float f32x4 __attribute__((ext_vector_type(4)));
typedef unsigned u32x4 __attribute__((ext_vector_type(4)));
constexpr int BM = 256, BK = 64, HALF = 128, HTB = HALF * BK * 2  , STAGE_BYTES = 8 * HTB, NXCD = 8, WGM = PG8_WGM;

__host__ __device__ __forceinline__ int lds_byte(int r, int c) { const int st = (r >> 4) * 2 + (c >> 5), rr = r & 15, cc = c & 31, ob = rr * 64 + cc * 2; return st * 1024 + (ob ^ (((ob >> 9) & 1) << 5)); }
__host__ __device__ __forceinline__ void stage_rc(int b, int& R, int& C) { const int st = b / 1024, sb = b % 1024, swz = sb ^ (((sb >> 9) & 1) << 5); R = (st >> 1) * 16 + swz / 64; C = (st & 1) * 32 + (swz % 64) / 2; }
__host__ __device__ __forceinline__ int perm32(int rho) { const int n = rho >> 4, i = rho & 15; return 8 * (i >> 2) + 4 * n + (i & 3); }

struct Unit { int pm, pn, pa, fl; };
struct Gemm { const bf16_t* A; const bf16_t* Bt; int M, N, K; };

struct StaticOrder {
    int nM, nN, nwg, G, c, wgm;
    __host__ __device__ void init(int M, int N, int G_, int c_) { nM = M / BM; nN = N / BM; nwg = nM * nN; G = G_; c = c_; wgm = WGM; }
    __host__ __device__ bool next(int i, Unit& u) const {
        const long L = (long)i * G + c; if (L >= nwg) return false;
        int wgid = (int)L; { const int q = nwg / NXCD, r = nwg % NXCD, xcd = wgid % NXCD, off = wgid / NXCD; wgid = (xcd < r ? xcd * (q + 1) : r * (q + 1) + (xcd - r) * q) + off; }
        const int nig = wgm * nN, gid = wgid / nig, fm = gid * wgm, gsz = (nM - fm) < wgm ? (nM - fm) : wgm;
        u.pm = fm + ((wgid % nig) % gsz); u.pn = (wgid % nig) / gsz; return true;
    }
    __device__ __forceinline__ void a_ready(const Unit&) const {}
    __device__ __forceinline__ void done(const Unit&) const {}
};

template <int ACT  > struct EpiStore {
    static constexpr bool PERM = true, AFTER_DRAIN = false;
    bf16_t* O; int ldc;
    __device__ __forceinline__ void operator()(const f32x4 (&acc)[2][2][4][2], const Unit& u, int wr, int wc, int fr, int fq) const {
        const int row0 = u.pm * BM + wr * 64 + fr; const int col0 = u.pn * BM + wc * 32 + 8 * fq;
#pragma unroll
        for (int ai = 0; ai < 2; ++ai)
#pragma unroll
            for (int m = 0; m < 4; ++m) { bf16_t* rowp = O + (size_t)(row0 + ai * HALF + m * 16) * ldc + col0;
#pragma unroll
                for (int bj = 0; bj < 2; ++bj) { f32x4 v0 = acc[ai][bj][m][0], v1 = acc[ai][bj][m][1];
                    if (ACT == 2) {
#pragma unroll
                        for (int e = 0; e < 4; ++e) { float a, b; asm("v_max_f32_e32 %0, 0, %1" : "=v"(a) : "v"(v0[e])); asm("v_max_f32_e32 %0, 0, %1" : "=v"(b) : "v"(v1[e]));
                            v0[e] = a * a; v1[e] = b * b; } }
                    u32x4 w; w.x = pk2(v0[0], v0[1]); w.y = pk2(v0[2], v0[3]); w.z = pk2(v1[0], v1[1]); w.w = pk2(v1[2], v1[3]);
                    *(u32x4*)(rowp + bj * HALF) = w; } }
    }
};
constexpr float QS_DIFF = 0.125f * 1.4426950408889634f;
struct EpiQK {
    static constexpr bool PERM = true, AFTER_DRAIN = false;
    bf16_t* O; int ldc; const f32x2* rd; const f32x2* rg; const float* qn; const float* kn; PG8_LAS float* scr;
    __device__ __forceinline__ void operator()(const f32x4 (&acc)[2][2][4][2], const Unit& u, int wr, int wc, int fr, int fq) const {
        const int pn = u.pn, pj = u.pm % 9; const bool lat = pj != 0; const int tbase = (pj - 1) * 256;
        const int type = (pn < 2 || pn == 12 || pn == 13) ? 1 : ((pn >= 2 && pn < 6) || pn == 16) ? 2 : 0;
        const int row0 = u.pm * BM + wr * 64 + fr; const int col0 = pn * BM + wc * 32 + 8 * fq;
        float rs[2][4][2];
        float wv[8];
#pragma unroll
        for (int e = 0; e < 8; ++e) wv[e] = 1.f;
        if (type == 2) {
            const float* gw = (pn == 16 ? kn : qn) + wc * 32 + 8 * fq;
#pragma unroll
            for (int e = 0; e < 8; ++e) wv[e] = gw[e];
#pragma unroll
            for (int ai = 0; ai < 2; ++ai)
#pragma unroll
                for (int m = 0; m < 4; ++m)
#pragma unroll
                    for (int bj = 0; bj < 2; ++bj) { const f32x4 a = acc[ai][bj][m][0], b = acc[ai][bj][m][1];
                        float s = (a[0] * a[0] + a[1] * a[1]) + (a[2] * a[2] + a[3] * a[3]) + (b[0] * b[0] + b[1] * b[1]) + (b[2] * b[2] + b[3] * b[3]);
                        s = sum_halves32(sum_rows16(s));
                        if (fq == 0) scr[(((wr * 128 + ai * 64 + m * 16 + fr) * 2) + bj) * 4 + wc] = s; }
            asm volatile("s_waitcnt lgkmcnt(0)" ::: "memory"); __builtin_amdgcn_s_barrier(); asm volatile("" ::: "memory");
#pragma unroll
            for (int ai = 0; ai < 2; ++ai)
#pragma unroll
                for (int m = 0; m < 4; ++m)
#pragma unroll
                    for (int bj = 0; bj < 2; ++bj) { const f32x4 p = *(const PG8_LAS f32x4*)(scr + (((wr * 128 + ai * 64 + m * 16 + fr) * 2) + bj) * 4);
                        rs[ai][m][bj] = frsq(((p[0] + p[1]) + (p[2] + p[3])) * (1.0f / 128.0f) + 1e-6f); }
        } else {
#pragma unroll
            for (int ai = 0; ai < 2; ++ai)
#pragma unroll
                for (int m = 0; m < 4; ++m) { rs[ai][m][0] = 1.f; rs[ai][m][1] = 1.f; }
        }
        const bool rope = lat && type != 0;
        if (type == 0) {
#pragma unroll
            for (int ai = 0; ai < 2; ++ai)
#pragma unroll
                for (int m = 0; m < 4; ++m) { bf16_t* rowp = O + (size_t)(row0 + ai * HALF + m * 16) * ldc + col0;
#pragma unroll
                    for (int bj = 0; bj < 2; ++bj) { const f32x4 v0 = acc[ai][bj][m][0], v1 = acc[ai][bj][m][1];
                        u32x4 w; w.x = pk2(v0[0], v0[1]); w.y = pk2(v0[2], v0[3]); w.z = pk2(v1[0], v1[1]); w.w = pk2(v1[2], v1[3]);
                        *(u32x4*)(rowp + bj * HALF) = w; } }
        } else if (type == 1) {
#pragma unroll
            for (int ai = 0; ai < 2; ++ai)
#pragma unroll
                for (int m = 0; m < 4; ++m) { bf16_t* rowp = O + (size_t)(row0 + ai * HALF + m * 16) * ldc + col0;
                    f32x2 cs[4];
#pragma unroll
                    for (int i = 0; i < 4; ++i) cs[i] = (f32x2){1.f, 0.f};
                    if (rope) { const int t = tbase + ai * HALF + wr * 64 + m * 16 + fr; const unsigned co = (unsigned)(t * 32 + 16 * (wc & 1) + 4 * fq) * 8u;
#pragma unroll
                        for (int i = 0; i < 4; ++i) cs[i] = *(const f32x2*)((const char*)rd + co + 8 * i); }
                    const float qs = pn < 2 ? QS_DIFF : 1.0f;
#pragma unroll
                    for (int bj = 0; bj < 2; ++bj) { const f32x4 v0 = acc[ai][bj][m][0], v1 = acc[ai][bj][m][1];
                        const float x[8] = {v0[0] * qs, v0[1] * qs, v0[2] * qs, v0[3] * qs, v1[0] * qs, v1[1] * qs, v1[2] * qs, v1[3] * qs};
                        u32x4 w;
#pragma unroll
                        for (int i = 0; i < 4; ++i) { const float x0 = x[2 * i], x1 = x[2 * i + 1]; w[i] = pk2(x0 * cs[i].x - x1 * cs[i].y, x0 * cs[i].y + x1 * cs[i].x); }
                        *(u32x4*)(rowp + bj * HALF) = w; } }
        } else {
#pragma unroll
            for (int ai = 0; ai < 2; ++ai)
#pragma unroll
                for (int m = 0; m < 4; ++m) { bf16_t* rowp = O + (size_t)(row0 + ai * HALF + m * 16) * ldc + col0;
                    f32x2 cs[4];
#pragma unroll
                    for (int i = 0; i < 4; ++i) cs[i] = (f32x2){1.f, 0.f};
                    if (rope) { const int t = tbase + ai * HALF + wr * 64 + m * 16 + fr; const unsigned co = (unsigned)(t * 64 + 16 * wc + 4 * fq) * 8u;
#pragma unroll
                        for (int i = 0; i < 4; ++i) cs[i] = *(const f32x2*)((const char*)rg + co + 8 * i); }
#pragma unroll
                    for (int bj = 0; bj < 2; ++bj) { const f32x4 v0 = acc[ai][bj][m][0], v1 = acc[ai][bj][m][1]; const float r_ = rs[ai][m][bj];
                        const float x[8] = {v0[0] * r_ * wv[0], v0[1] * r_ * wv[1], v0[2] * r_ * wv[2], v0[3] * r_ * wv[3], v1[0] * r_ * wv[4], v1[1] * r_ * wv[5], v1[2] * r_ * wv[6], v1[3] * r_ * wv[7]};
                        u32x4 w;
#pragma unroll
                        for (int i = 0; i < 4; ++i) { const float x0 = x[2 * i], x1 = x[2 * i + 1]; w[i] = pk2(x0 * cs[i].x - x1 * cs[i].y, x0 * cs[i].y + x1 * cs[i].x); }
                        *(u32x4*)(rowp + bj * HALF) = w; } }
        }
    }
};
}
__device__ void g1_mid_barrier(unsigned* barw, unsigned x);
namespace pg8 {
struct PanelSched {
    StaticOrder so; int base; bool latent_only, a_local, o_local; int deal; unsigned* midbar = nullptr; unsigned midx = 0; bool own = false, ctxown = false;
    __device__ __forceinline__ bool next(int i, Unit& u) const {
        u.fl = 0;
        if (deal == 0) { if (!so.next(i, u)) return false; }
        else if (deal == 5) {
            const int c = so.c, x = c & 7, uu = 32 * i + (c >> 3); if (uu >= 144) return false;
            const int g = uu >> 5, v = uu & 31;
            if (g < 4) { u.pm = 18 * x + 4 * g + (v & 3); u.pn = v >> 2; } else { u.pm = 18 * x + 16 + (v & 1); u.pn = v >> 1; }
            if (midbar != nullptr && i == 3 && (c >> 3) < 16) u.fl = 1;
            u.pa = u.pm; return true; }
        else if (deal == 6) {
            const int c = so.c, x = c & 7, uu = 32 * i + (c >> 3); if (uu >= 324) return false;
            if (uu < 288) { const int g = uu / 72, v = uu - 72 * g; u.pm = 18 * x + 4 * g + (v & 3); u.pn = v >> 2; } else { const int v = uu - 288; u.pm = 18 * x + 16 + (v & 1); u.pn = v >> 1; }
            if (midbar != nullptr && i == 9 && (c >> 3) < 4) u.fl = 1;
            u.pa = u.pm; return true; }
        else if (deal == 2) {
            if (i < 9) { if (!so.next(i, u)) return false; if (midbar != nullptr && i == 8 && (so.c >> 3) < 12) u.fl = 1; }
            else { const int c = so.c; if (i > 9 || c >= 96) return false;
                if (ctxown) { const int rk = c >> 3; u.pm = 9 * (2 * (c & 7) + rk / 6); u.pn = 12 + rk % 6; }
                else { u.pm = 9 * ((c & 7) + 8 * (c / 48)); u.pn = 12 + ((c >> 3) % 6); }
                u.pa = u.pm; return true; } }
        else { const int c = so.c; int L;
            if (c < 128) { if (i >= 2) return false; L = i * 128 + c; } else { if (i >= 6) return false; L = 256 + i * 128 + (c - 128); }
            StaticOrder t = so; t.G = 0; t.c = L; if (!t.next(0, u)) return false; }
        const int lp = base + u.pm; int act;
        if (own) {
            const int c_ = lp >> 5, r_ = lp & 31;
            if (latent_only) { const int ll = 16 * (r_ >> 2) + 4 * c_ + (r_ & 3); act = (ll >> 3) * 9 + 1 + (ll & 7); }
            else if (lp < 128) act = 18 * (r_ >> 2) + 4 * c_ + (r_ & 3);
            else { const int e_ = lp - 128; act = 18 * (e_ >> 1) + 16 + (e_ & 1); } }
        else act = latent_only ? (lp >> 3) * 9 + 1 + (lp & 7) : lp;
        u.pa = a_local ? u.pm : act; u.pm = o_local ? u.pm : act; return true;
    }
    __device__ __forceinline__ void a_ready(const Unit&) const {}
    __device__ __forceinline__ void done(const Unit& u) const { if (u.fl) g1_mid_barrier(midbar, midx); }
};

template <class Epi, class Sched, bool ALIGN_EPI = false, bool SP2 = false>
__device__ __forceinline__ void gemm_phase(PG8_LAS unsigned char* lds, const Gemm g, const Sched& S, const Epi& E) {
    const int tid = opaque_tid(), wid = __builtin_amdgcn_readfirstlane(tid >> 6), lane = tid & 63, wr = wid >> 2, wc = wid & 3, fr = lane & 15, fq = lane >> 4;
    const int K = g.K, nt = K / BK;
    unsigned voffA[2], voffB[2];
#pragma unroll
    for (int i = 0; i < 2; ++i) { int R, C; stage_rc(tid * 16 + i * 8192, R, C); const int Rb = Epi::PERM ? ((R & ~31) + perm32(R & 31)) : R;
        voffA[i] = (unsigned)(R * K + C) * 2u; voffB[i] = (unsigned)(Rb * K + C) * 2u; }
    const size_t kstep = (size_t)(BK * 2);
    const size_t hstep = (size_t)HALF * K * 2;
    const size_t tstep = 2 * hstep;
    const unsigned ldsw = (unsigned)wid * 1024u;
    const int aoff = lds_byte(wr * 64 + fr, fq * 8), boff = lds_byte(wc * 32 + fr, fq * 8);
#define PG8_SA(b, h) (((b) * 2 + (h)) * HTB)
#define PG8_SB(b, h) ((4 + (b) * 2 + (h)) * HTB)
#define PG8_STAGE(bufoff, gbase, voff) do { _Pragma("unroll") for (int _i = 0; _i < 2; ++_i) \
        __builtin_amdgcn_global_load_lds((const unsigned*)((const char*)(gbase) + (voff)[_i]), (PG8_LAS unsigned*)(lds + (bufoff) + ldsw + _i * 8192), 16, 0, 0); } while (0)
#define PG8_LDA(dst, b, h) do { _Pragma("unroll") for (int m = 0; m < 4; ++m) _Pragma("unroll") for (int k = 0; k < 2; ++k) dst[m][k] = *(const PG8_LAS bf16x8*)(lds + PG8_SA(b, h) + aoff + m * 2048 + k * 1024); } while (0)
#define PG8_LDB(dst, b, h) do { _Pragma("unroll") for (int n = 0; n < 2; ++n) _Pragma("unroll") for (int k = 0; k < 2; ++k) dst[n][k] = *(const PG8_LAS bf16x8*)(lds + PG8_SB(b, h) + boff + n * 2048 + k * 1024); } while (0)
#define PG8_MMA(ai, bj, At, Bt) do { __builtin_amdgcn_s_setprio(1); _Pragma("unroll") for (int m = 0; m < 4; ++m) _Pragma("unroll") for (int n = 0; n < 2; ++n) _Pragma("unroll") for (int k = 0; k < 2; ++k) \
        acc[ai][bj][m][n] = __builtin_amdgcn_mfma_f32_16x16x32_bf16(Bt[n][k], At[m][k], acc[ai][bj][m][n], 0, 0, 0); __builtin_amdgcn_s_setprio(0); } while (0)
#define PG8_WAIT_V(n) asm volatile("s_waitcnt vmcnt(" #n ")" ::: "memory")
#define PG8_WAIT_L(n) asm volatile("s_waitcnt lgkmcnt(" #n ")" ::: "memory")
#define PG8_BAR __builtin_amdgcn_s_barrier()
#define PG8_SCHED __builtin_amdgcn_sched_barrier(0)
    Unit cur, nxt; int ui = 0;
    if (!S.next(0, cur)) return;
    f32x4 acc[2][2][4][2];
#pragma unroll
    for (int a = 0; a < 2; ++a)
#pragma unroll
        for (int b = 0; b < 2; ++b)
#pragma unroll
            for (int m = 0; m < 4; ++m)
#pragma unroll
                for (int n = 0; n < 2; ++n) acc[a][b][m][n] = (f32x4){0.f, 0.f, 0.f, 0.f};
    bf16x8 At[4][2], B0[2][2], B1[2][2];
    const char* cA = (const char*)g.A + (size_t)cur.pa * tstep; const char* cB = (const char*)g.Bt + (size_t)cur.pn * tstep;
    S.a_ready(cur);
    if constexpr (SP2) {
        PG8_STAGE(PG8_SB(0, 0), cB, voffB); PG8_STAGE(PG8_SB(0, 1), cB + hstep, voffB); PG8_STAGE(PG8_SA(0, 0), cA, voffA); PG8_STAGE(PG8_SA(0, 1), cA + hstep, voffA);
        if (wr == 1) PG8_BAR;
        PG8_WAIT_V(2); PG8_BAR;
        PG8_STAGE(PG8_SB(1, 0), cB + kstep, voffB); PG8_STAGE(PG8_SA(1, 0), cA + kstep, voffA); PG8_STAGE(PG8_SB(1, 1), cB + hstep + kstep, voffB);
        PG8_WAIT_V(6); PG8_BAR;
    } else {
        PG8_STAGE(PG8_SB(0, 0), cB, voffB); PG8_STAGE(PG8_SA(0, 0), cA, voffA); PG8_STAGE(PG8_SB(0, 1), cB + hstep, voffB); PG8_STAGE(PG8_SA(0, 1), cA + hstep, voffA);
        if (wr == 1) PG8_BAR;
        PG8_WAIT_V(4); PG8_BAR;
        PG8_STAGE(PG8_SB(1, 0), cB + kstep, voffB); PG8_STAGE(PG8_SA(1, 0), cA + kstep, voffA); PG8_STAGE(PG8_SB(1, 1), cB + hstep + kstep, voffB);
        PG8_WAIT_V(6); PG8_BAR;
    }
    for (;;) {
        const bool has_next = S.next(ui + 1, nxt);
        const char* nA = has_next ? (const char*)g.A + (size_t)nxt.pa * tstep : cA; const char* nB = has_next ? (const char*)g.Bt + (size_t)nxt.pn * tstep : cB;
        for (int t = 0; t < nt; t += 2) {
            const bool last = (t == nt - 2);
            const char* a1 = cA + (size_t)(t + 1) * kstep;
            const char* a2 = last ? nA : cA + (size_t)(t + 2) * kstep; const char* b2 = last ? nB : cB + (size_t)(t + 2) * kstep;
            const char* a3 = a2 + kstep; const char* b3 = b2 + kstep;
            if (last && has_next) S.a_ready(nxt);
            if constexpr (SP2) {
            PG8_LDB(B0, 0, 0); PG8_LDB(B1, 0, 1); PG8_SCHED; PG8_LDA(At, 0, 0); PG8_STAGE(PG8_SA(1, 1), a1 + hstep, voffA);
            PG8_WAIT_V(8); PG8_WAIT_L(0); PG8_BAR; PG8_MMA(0, 0, At, B0); PG8_MMA(0, 1, At, B1); PG8_BAR; PG8_SCHED;
            PG8_LDA(At, 0, 1); PG8_STAGE(PG8_SB(0, 0), b2, voffB); PG8_STAGE(PG8_SB(0, 1), b2 + hstep, voffB); PG8_STAGE(PG8_SA(0, 0), a2, voffA);
            PG8_WAIT_V(8); PG8_WAIT_L(0); PG8_BAR; PG8_MMA(1, 0, At, B0); PG8_MMA(1, 1, At, B1); PG8_BAR; PG8_SCHED;
            PG8_LDB(B0, 1, 0); PG8_LDB(B1, 1, 1); PG8_SCHED; PG8_LDA(At, 1, 0); PG8_STAGE(PG8_SA(0, 1), a2 + hstep, voffA);
            PG8_WAIT_V(8); PG8_WAIT_L(0); PG8_BAR; PG8_MMA(0, 0, At, B0); PG8_MMA(0, 1, At, B1); PG8_BAR; PG8_SCHED;
            PG8_LDA(At, 1, 1); PG8_STAGE(PG8_SB(1, 0), b3, voffB); PG8_STAGE(PG8_SB(1, 1), b3 + hstep, voffB); PG8_STAGE(PG8_SA(1, 0), a3, voffA);
            PG8_WAIT_V(8); PG8_WAIT_L(0); PG8_BAR; PG8_MMA(1, 0, At, B0); PG8_MMA(1, 1, At, B1); PG8_BAR; PG8_SCHED;
            } else {
            PG8_LDB(B0, 0, 0); PG8_SCHED; PG8_LDA(At, 0, 0); PG8_STAGE(PG8_SA(1, 1), a1 + hstep, voffA);
            PG8_WAIT_L(8); PG8_BAR; PG8_WAIT_L(0); PG8_MMA(0, 0, At, B0); PG8_BAR; PG8_SCHED;
            PG8_LDB(B1, 0, 1); PG8_STAGE(PG8_SB(0, 0), b2, voffB);
            PG8_BAR; PG8_WAIT_L(0); PG8_MMA(0, 1, At, B1); PG8_BAR;
            PG8_LDA(At, 0, 1); PG8_STAGE(PG8_SA(0, 0), a2, voffA);
            PG8_BAR; PG8_WAIT_L(0); PG8_MMA(1, 0, At, B0); PG8_BAR; PG8_SCHED;
            PG8_STAGE(PG8_SB(0, 1), b2 + hstep, voffB);
            PG8_WAIT_V(6); PG8_BAR; PG8_MMA(1, 1, At, B1); PG8_BAR;
            PG8_LDB(B0, 1, 0); PG8_SCHED; PG8_LDA(At, 1, 0); PG8_STAGE(PG8_SA(0, 1), a2 + hstep, voffA);
            PG8_WAIT_L(8); PG8_BAR; PG8_WAIT_L(0); PG8_MMA(0, 0, At, B0); PG8_BAR; PG8_SCHED;
            PG8_LDB(B1, 1, 1); PG8_STAGE(PG8_SB(1, 0), b3, voffB);
            PG8_BAR; PG8_WAIT_L(0); PG8_MMA(0, 1, At, B1); PG8_BAR;
            PG8_LDA(At, 1, 1); PG8_STAGE(PG8_SA(1, 0), a3, voffA);
            PG8_BAR; PG8_WAIT_L(0); PG8_MMA(1, 0, At, B0); PG8_BAR; PG8_SCHED;
            PG8_STAGE(PG8_SB(1, 1), b3 + hstep, voffB);
            PG8_WAIT_V(6); PG8_BAR; PG8_MMA(1, 1, At, B1); PG8_BAR;
            }
        }
        if constexpr (ALIGN_EPI) { if (wr == 0) PG8_BAR; }
        if constexpr (!Epi::AFTER_DRAIN) { E(acc, cur, wr, wc, fr, fq); S.done(cur); }
        if (!has_next) break;
#pragma unroll
        for (int a = 0; a < 2; ++a)
#pragma unroll
            for (int b = 0; b < 2; ++b)
#pragma unroll
                for (int m = 0; m < 4; ++m)
#pragma unroll
                    for (int n = 0; n < 2; ++n) acc[a][b][m][n] = (f32x4){0.f, 0.f, 0.f, 0.f};
        cur = nxt; cA = nA; cB = nB; ++ui;
        if constexpr (ALIGN_EPI) { if (wr == 1) PG8_BAR; }
    }
    PG8_WAIT_V(0);
    if constexpr (!ALIGN_EPI) { if (wr == 0) PG8_BAR; }
    PG8_BAR;
    if constexpr (Epi::AFTER_DRAIN) { E.fused(acc, cur, wr, wc, fr, fq, lds, wid, lane); S.done(cur); }
#undef PG8_SA
#undef PG8_SB
#undef PG8_STAGE
#undef PG8_LDA
#undef PG8_LDB
#undef PG8_MMA
#undef PG8_WAIT_V
#undef PG8_WAIT_L
#undef PG8_BAR
#undef PG8_SCHED
}
}
namespace att {
constexpr int NW = 8, QBLK = 32, KVBLK = 64, LDH = NIN;
constexpr float THR = 16.f;
constexpr size_t SHM_V = KVBLK * 128 * 2, SHM_K = KVBLK * 128 * 2, SHM_ATTN = 2 * SHM_V + 2 * SHM_K + NW * 64 * 4;
#define KSWZ(row, colB) ((row) * 256 + ((colB) ^ (((row) & 7) << 4)))
#define SBAR() __builtin_amdgcn_sched_barrier(0)
DI int crow(int r, int hi) { return (r & 3) + 8 * (r >> 2) + 4 * hi; }
DI unsigned cvtpk(float lo, float hi) { unsigned r; asm volatile("v_cvt_pk_bf16_f32 %0, %1, %2" : "=v"(r) : "v"(lo), "v"(hi)); return r; }

DI float max3a(float a, float b, float c) { float d; asm("v_max3_f32 %0, %1, %2, %3" : "=v"(d) : "v"(a), "v"(b), "v"(c)); return d; }
DI float max2a(float a, float b) { float d; asm("v_max_f32_e32 %0, %1, %2" : "=v"(d) : "v"(a), "v"(b)); return d; }
DI float maxchain(float m, const f32x16& p) {
  asm("v_max3_f32 %0, %0, %1, %2\n\tv_max3_f32 %0, %0, %3, %4\n\tv_max3_f32 %0, %0, %5, %6\n\tv_max3_f32 %0, %0, %7, %8\n\tv_max3_f32 %0, %0, %9, %10\n\tv_max3_f32 %0, %0, %11, %12\n\tv_max3_f32 %0, %0, %13, %14"
      : "+v"(m) : "v"(p[2]), "v"(p[3]), "v"(p[4]), "v"(p[5]), "v"(p[6]), "v"(p[7]), "v"(p[8]), "v"(p[9]), "v"(p[10]), "v"(p[11]), "v"(p[12]), "v"(p[13]), "v"(p[14]), "v"(p[15]));
  return m; }
template <int KB> DI float fmamk(float p, float m) { float d; asm("v_fmamk_f32 %0, %1, %3, %2" : "=v"(d) : "v"(p), "v"(m), "n"(KB)); return d; }
template <int CB>
DI void partialSM(f32x16& p0, f32x16& p1, float& m_reg, float& mn, float& alpha, const float C, const float THRS, const float INF  ) {
  float ma = __builtin_amdgcn_fmed3f(p0[0], p0[1], INF), mb = __builtin_amdgcn_fmed3f(p1[0], p1[1], INF);
  ma = maxchain(ma, p0); mb = maxchain(mb, p1);
  float pmax = max2a(ma, mb);
  { auto rr = __builtin_amdgcn_permlane32_swap(__float_as_uint(pmax), __float_as_uint(pmax), false, false);
    pmax = max2a(__uint_as_float(rr[0]), __uint_as_float(rr[1])); }
  if (__builtin_expect(__all(pmax - m_reg <= THRS), 1)) { mn = m_reg; alpha = 1.f; }
  else { asm volatile("; new row max");
    mn = max2a(m_reg, pmax); alpha = __builtin_amdgcn_exp2f((m_reg - mn) * C); m_reg = mn; }
  const float mnC = -mn * C;
#pragma unroll
  for (int r = 0; r < 16; ++r) p0[r] = fmamk<CB>(p0[r], mnC);
#pragma unroll
  for (int r = 0; r < 16; ++r) p1[r] = fmamk<CB>(p1[r], mnC);
#pragma unroll
  for (int r = 0; r < 16; ++r) p0[r] = __builtin_amdgcn_exp2f(p0[r]);
}
template <bool FIRST>
DI void partialSM2(f32x16& p0, f32x16& p1, f32x16& negm, float& alpha, const float THR2, const float INF) {
  float ma = __builtin_amdgcn_fmed3f(p0[0], p0[1], INF), mb = __builtin_amdgcn_fmed3f(p1[0], p1[1], INF);
  ma = maxchain(ma, p0); mb = maxchain(mb, p1);
  float pmax = max2a(ma, mb);
  { auto rr = __builtin_amdgcn_permlane32_swap(__float_as_uint(pmax), __float_as_uint(pmax), false, false);
    pmax = max2a(__uint_as_float(rr[0]), __uint_as_float(rr[1])); }
  if (!FIRST && __builtin_expect(__all(pmax <= THR2), 1)) { alpha = 1.f; }
  else { if (!FIRST) asm volatile("; new row max");
    const float delta = FIRST ? pmax : max2a(pmax, 0.f);
    alpha = FIRST ? 1.f : __builtin_amdgcn_exp2f(-delta);
    const float nm = negm[0] - delta;
#pragma unroll
    for (int r = 0; r < 16; ++r) { p0[r] -= delta; p1[r] -= delta; negm[r] = nm; } }
#pragma unroll
  for (int r = 0; r < 16; ++r) p0[r] = __builtin_amdgcn_exp2f(p0[r]);
}
DI void finishSM(f32x16& p0, f32x16& p1, float alpha, float& l_reg, bf16x8& pa0, bf16x8& pa1, bf16x8& pa2, bf16x8& pa3) {
#pragma unroll
  for (int r = 0; r < 16; ++r) p1[r] = __builtin_amdgcn_exp2f(p1[r]);
  float ps = 0;
#pragma unroll
  for (int r = 0; r < 16; ++r) ps += p0[r];
#pragma unroll
  for (int r = 0; r < 16; ++r) ps += p1[r];
  { auto rr = __builtin_amdgcn_permlane32_swap(__float_as_uint(ps), __float_as_uint(ps), false, false);
    ps = __uint_as_float(rr[0]) + __uint_as_float(rr[1]); }
  l_reg = l_reg * alpha + ps;
#define PK4(P, BASE, OUT) do { unsigned a0 = cvtpk(P[BASE + 0], P[BASE + 1]), a1 = cvtpk(P[BASE + 2], P[BASE + 3]);   \
    unsigned b0 = cvtpk(P[BASE + 4], P[BASE + 5]), b1 = cvtpk(P[BASE + 6], P[BASE + 7]);                              \
    auto r0 = __builtin_amdgcn_permlane32_swap(a0, b0, false, false); auto r1 = __builtin_amdgcn_permlane32_swap(a1, b1, false, false); \
    u32x4 w = {r0[0], r1[0], r0[1], r1[1]}; OUT = *reinterpret_cast<bf16x8*>(&w); } while (0)
  PK4(p0, 0, pa0); PK4(p0, 8, pa1); PK4(p1, 0, pa2); PK4(p1, 8, pa3);
#undef PK4
}
template <int ND0> DI void qkt(f32x16& p0, f32x16& p1, const char* Ks, const bf16x8* qr, int r32, int hi, int cb0, const f32x16& init) {
  p0 = init; p1 = init;
#pragma unroll
  for (int d0 = 0; d0 < ND0; ++d0) { const int cb = cb0 + (d0 * 16 + hi * 8) * 2;
    const bf16x8 b0 = *reinterpret_cast<const bf16x8*>(Ks + KSWZ(r32, cb));
    const bf16x8 b1 = *reinterpret_cast<const bf16x8*>(Ks + KSWZ(32 + r32, cb));
    p0 = __builtin_amdgcn_mfma_f32_32x32x16_bf16(b0, qr[d0], p0, 0, 0, 0);
    p1 = __builtin_amdgcn_mfma_f32_32x32x16_bf16(b1, qr[d0], p1, 0, 0, 0); }
}
DI int v_st(int k, int c) { const int kk = (k & ~0xC) | ((k & 4) << 1) | ((k & 8) >> 1); return ((kk >> 3) * 4 + (c >> 5)) * 512 + ((kk & 7) * 32 + (c & 31)) * 2; }
DI int v_rd_base(int lane) { return ((lane & 3) << 3) | (((lane >> 2) & 3) << 6) | (((lane >> 4) & 1) << 5) | (((lane >> 5) & 1) << 8); }
constexpr int v_rd_off(int d0, int ks, int half) { return d0 * 512 + ks * 4096 + half * 2048; }
template <int OFF> DI s16x4 tr_read(int vb) {
  s16x4 r; asm volatile("ds_read_b64_tr_b16 %0, %1 offset:%2" : "=&v"(r) : "v"(vb), "i"(OFF) : "memory"); return r;
}
template <int D0> DI void pv_one(f32x16& od, int vb, bf16x8 pa0, bf16x8 pa1, bf16x8 pa2, bf16x8 pa3) {
  const s16x4 l0 = tr_read<v_rd_off(D0, 0, 0)>(vb), h0 = tr_read<v_rd_off(D0, 0, 1)>(vb), l1 = tr_read<v_rd_off(D0, 1, 0)>(vb), h1 = tr_read<v_rd_off(D0, 1, 1)>(vb);
  const s16x4 l2 = tr_read<v_rd_off(D0, 2, 0)>(vb), h2 = tr_read<v_rd_off(D0, 2, 1)>(vb), l3 = tr_read<v_rd_off(D0, 3, 0)>(vb), h3 = tr_read<v_rd_off(D0, 3, 1)>(vb);
  asm volatile("s_waitcnt lgkmcnt(0)" ::: "memory"); SBAR();
#define PK(L, H) (bf16x8){L[0], L[1], L[2], L[3], H[0], H[1], H[2], H[3]}
  od = __builtin_amdgcn_mfma_f32_32x32x16_bf16(pa0, PK(l0, h0), od, 0, 0, 0);
  od = __builtin_amdgcn_mfma_f32_32x32x16_bf16(pa1, PK(l1, h1), od, 0, 0, 0);
  od = __builtin_amdgcn_mfma_f32_32x32x16_bf16(pa2, PK(l2, h2), od, 0, 0, 0);
  od = __builtin_amdgcn_mfma_f32_32x32x16_bf16(pa3, PK(l3, h3), od, 0, 0, 0);
#undef PK
}
DI void pv_d0(f32x16* o, int vb, bf16x8 pa0, bf16x8 pa1, bf16x8 pa2, bf16x8 pa3) {
  pv_one<0>(o[0], vb, pa0, pa1, pa2, pa3); pv_one<1>(o[1], vb, pa0, pa1, pa2, pa3); pv_one<2>(o[2], vb, pa0, pa1, pa2, pa3); pv_one<3>(o[3], vb, pa0, pa1, pa2, pa3);
}

template <int MODE>
DI void attn_unit(const u16* __restrict__ Qb, const u16* __restrict__ Kh, const u16* __restrict__ Vh, int seq, char* lds,
                  u16* __restrict__ Ob, const float* __restrict__ gvec, float lam, float post) {
  constexpr int ND0 = MODE ? 4 : 8;
  constexpr float SCALE = MODE ? 0.125f : 0.088388347648318440f;
  constexpr float C = SCALE * 1.4426950408889634f, THRS = THR / SCALE; constexpr int CB = __builtin_bit_cast(int, C); constexpr float THR2 = THR * 1.4426950408889634f;
  int tid_ = ktid(); asm volatile("" : "+v"(tid_));
  const int tid = tid_, wid = __builtin_amdgcn_readfirstlane(tid >> 6), lane = tid & 63, r32 = lane & 31, hi = lane >> 5;
  int infb_ = 0x7f800000; asm("" : "+s"(infb_)); const float INF = __int_as_float(infb_);
  const int wq = MODE ? (wid & 3) : wid, mp = MODE ? (wid >> 2) : 0;
  char* V_lds = lds; char* K_lds = lds + 2 * SHM_V;
  float* ws = (float*)(lds + 2 * SHM_V + 2 * SHM_K) + wid * 64; float* li_l = ws; float* al_l = ws + 32;
  float m_reg = -1e30f, l_reg = 0; f32x16 o[4] = {}; f32x16 negm = {}; bf16x8 qr[ND0];
  const u16* Qw = Qb + (long)(wq * QBLK + r32) * LDH + mp * 64 + hi * 8;
#pragma unroll
  for (int d0 = 0; d0 < ND0; ++d0) qr[d0] = *reinterpret_cast<const bf16x8*>(Qw + d0 * 16);
  const int cb0 = mp * 128;
  const int sr = tid >> 4, sc = (tid & 15) * 8, vst0 = v_st(sr, sc), vst1 = v_st(32 + sr, sc);
  const int vb0 = (int)(uintptr_t)V_lds + v_rd_base(lane);
  struct { bf16x8 vs0, vs1, ks0, ks1; } sr_[2];
#define SLOAD(i, k0) do { sr_[i].vs0 = *reinterpret_cast<const bf16x8*>(&Vh[(long)((k0) + sr) * LDH + sc]); sr_[i].vs1 = *reinterpret_cast<const bf16x8*>(&Vh[(long)((k0) + 32 + sr) * LDH + sc]); \
    sr_[i].ks0 = *reinterpret_cast<const bf16x8*>(&Kh[(long)((k0) + sr) * LDH + sc]); sr_[i].ks1 = *reinterpret_cast<const bf16x8*>(&Kh[(long)((k0) + 32 + sr) * LDH + sc]); } while (0)
#define SWRITE(b, i) do { *(bf16x8*)(V_lds + (b) * SHM_V + vst0) = sr_[i].vs0;          \
    *(bf16x8*)(V_lds + (b) * SHM_V + vst1) = sr_[i].vs1; const int kc = sc * 2;               \
    *(bf16x8*)(K_lds + (b) * SHM_K + KSWZ(sr, kc)) = sr_[i].ks0;                       \
    *(bf16x8*)(K_lds + (b) * SHM_K + KSWZ(32 + sr, kc)) = sr_[i].ks1; } while (0)
#define SWAIT() asm volatile("s_waitcnt vmcnt(4)" ::: "memory")
#define RESC(a) do { if (__any((a) < 1.f)) { if (hi == 0) al_l[r32] = (a); asm volatile("s_waitcnt lgkmcnt(0)" ::: "memory"); \
    _Pragma("unroll") for (int d = 0; d < 4; ++d) _Pragma("unroll") for (int r = 0; r < 16; ++r) o[d][r] *= al_l[crow(r, hi)]; } } while (0)
#define PSM(FIRST, p0, p1, mn, al) do { if constexpr (MODE != 0) partialSM2<FIRST>(p0, p1, negm, al, THR2, INF); else partialSM<CB>(p0, p1, m_reg, mn, al, C, THRS, INF); } while (0)
  f32x16 pA0, pA1, pB0, pB1; float mnA, mnB, alA, alB; bf16x8 pa0, pa1, pa2, pa3; const int NT = seq / KVBLK;
  constexpr int SE = 0, SO = 1;
  SLOAD(SE, 0); asm volatile("s_waitcnt vmcnt(0)" ::: "memory"); SWRITE(0, SE); __syncthreads();
  qkt<ND0>(pA0, pA1, K_lds, qr, r32, hi, cb0, negm); PSM(true, pA0, pA1, mnA, alA);
  SLOAD(SO, KVBLK); if (2 < NT) SLOAD(SE, 2 * KVBLK);
  SWAIT(); SWRITE(1, SO); __syncthreads();
  for (int j = 1; j + 1 < NT; j += 2) {
    SBAR(); qkt<ND0>(pB0, pB1, K_lds + SHM_K, qr, r32, hi, cb0, negm);
    finishSM(pA0, pA1, alA, l_reg, pa0, pa1, pa2, pa3); SBAR();
    SLOAD(SO, (j + 2) * KVBLK); SBAR();
    pv_d0(o, vb0, pa0, pa1, pa2, pa3); PSM(false, pB0, pB1, mnB, alB);
    __syncthreads(); SWAIT(); SWRITE(0, SE);
    RESC(alB); __syncthreads();
    SBAR(); qkt<ND0>(pA0, pA1, K_lds, qr, r32, hi, cb0, negm);
    finishSM(pB0, pB1, alB, l_reg, pa0, pa1, pa2, pa3); SBAR();
    if (j + 3 < NT) SLOAD(SE, (j + 3) * KVBLK); SBAR();
    pv_d0(o, vb0 + (int)SHM_V, pa0, pa1, pa2, pa3); PSM(false, pA0, pA1, mnA, alA);
    __syncthreads(); SWAIT(); SWRITE(1, SO);
    RESC(alA); __syncthreads();
  }
  SBAR(); qkt<ND0>(pB0, pB1, K_lds + SHM_K, qr, r32, hi, cb0, negm);
  finishSM(pA0, pA1, alA, l_reg, pa0, pa1, pa2, pa3); SBAR();
  pv_d0(o, vb0, pa0, pa1, pa2, pa3); PSM(false, pB0, pB1, mnB, alB);
  __syncthreads(); RESC(alB);
  finishSM(pB0, pB1, alB, l_reg, pa0, pa1, pa2, pa3); SBAR();
  pv_d0(o, vb0 + (int)SHM_V, pa0, pa1, pa2, pa3);
  if (hi == 0) li_l[r32] = l_reg; asm volatile("s_waitcnt lgkmcnt(0)" ::: "memory");
  float rli[16];
#pragma unroll
  for (int r = 0; r < 16; ++r) rli[r] = __builtin_amdgcn_rcpf(li_l[crow(r, hi)]);
#pragma unroll
  for (int d0 = 0; d0 < 4; ++d0)
#pragma unroll
    for (int r = 0; r < 16; ++r) o[d0][r] *= rli[r];
  if (MODE) {
    __syncthreads();
    float* ex = (float*)lds + (wq * 64) * 64 + lane;
    if (mp == 1) {
#pragma unroll
      for (int d0 = 0; d0 < 4; ++d0)
#pragma unroll
        for (int r = 0; r < 16; ++r) ex[(d0 * 16 + r) * 64] = o[d0][r];
    }
    __syncthreads();
    if (mp == 0) {
#pragma unroll
      for (int d0 = 0; d0 < 4; ++d0)
#pragma unroll
        for (int r = 0; r < 16; ++r) o[d0][r] -= lam * ex[(d0 * 16 + r) * 64];
    }
  }
  if (mp == 0) {
    float gw[4];
#pragma unroll
    for (int d0 = 0; d0 < 4; ++d0) gw[d0] = gvec[d0 * 32 + r32] * post;
    u16* Ow = Ob + (long)(wq * QBLK) * DM;
#pragma unroll
    for (int r = 0; r < 16; ++r) {
      float s = 0.f;
#pragma unroll
      for (int d0 = 0; d0 < 4; ++d0) s += o[d0][r] * o[d0][r];
      s = sum32(s);
      const float rs = frsq(s * (1.0f / 128.0f) + EPS);
      const int orow = crow(r, hi);
#pragma unroll
      for (int d0 = 0; d0 < 4; ++d0) Ow[(long)orow * DM + d0 * 32 + r32] = tobf(o[d0][r] * rs * gw[d0]);
    }
  }
  __syncthreads();
#undef SLOAD
#undef SWRITE
#undef SWAIT
#undef RESC
#undef PSM
}
#undef SBAR
}

template <int N>
DI void hyena_unit(const u16* __restrict__ KFc, const u16* __restrict__ ZTc, u16* __restrict__ YTc, char* ldsg) {
  constexpr int CL = 2 * N + 8, CS = CL * 2 + 16;
  constexpr int BS = N * 2 + 16;
  constexpr int BOFF = 8 * CS;
  constexpr int NMT = N / 128;
  LAS char* lds = (LAS char*)ldsg;
  int tid_ = ktid(); asm volatile("" : "+v"(tid_));
  const int tid = tid_, wid = __builtin_amdgcn_readfirstlane(tid >> 6), lane = tid & 63;
  for (int e = tid; e < 2 * N / 8; e += 512) { const bf16x8 v = *reinterpret_cast<const bf16x8*>(KFc + 8 * e);
#pragma unroll
    for (int jj = 0; jj < 8; ++jj) { const int y = 2 * N - (8 * e + jj);
#pragma unroll
      for (int r = 0; r < 8; ++r) *(LAS u16*)(lds + r * CS + 2 * (y + r)) = (u16)v[jj]; } }
  for (int e = tid; e < 16 * (N / 8); e += 512) { const int b = e / (N / 8), ch = e - b * (N / 8);
    *(LAS bf16x8*)(lds + BOFF + b * BS + 16 * ch) = *reinterpret_cast<const bf16x8*>(ZTc + (long)b * RPB + 8 * ch); }
  __syncthreads();
  const int i = lane & 15, q = lane >> 4, r = i & 7;
  const int abase = r * CS + 2 * (N - (i - r) + 8 * q) - 32 * (wid * NMT);
  const int bbase = BOFF + i * BS + 16 * q;
  f32x4 acc[NMT];
#pragma unroll
  for (int mi = 0; mi < NMT; ++mi) acc[mi] = (f32x4){0.f, 0.f, 0.f, 0.f};
  bf16x8 F[NMT];
#pragma unroll
  for (int mi = 2; mi < NMT; ++mi) F[(NMT - mi) % NMT] = *(const LAS bf16x8*)(lds + abase - 32 * mi);
  constexpr int UNR = NMT / 2;
  for (int kt0 = 0; kt0 < N / 32; kt0 += UNR) {
#pragma unroll
    for (int kk = 0; kk < UNR; ++kk) { const int kt = kt0 + kk;
      F[(2 * kk + NMT - 1) % NMT] = *(const LAS bf16x8*)(lds + abase + 32 * (2 * kt - 1));
      F[(2 * kk) % NMT] = *(const LAS bf16x8*)(lds + abase + 32 * (2 * kt));
      const bf16x8 bf = *(const LAS bf16x8*)(lds + bbase + 64 * kt);
#pragma unroll
      for (int mi = NMT - 1; mi >= 0; --mi) acc[mi] = __builtin_amdgcn_mfma_f32_16x16x32_bf16(F[(2 * kk - mi + 2 * NMT) % NMT], bf, acc[mi], 0, 0, 0);
    }
  }
#pragma unroll
  for (int mi = 0; mi < NMT; ++mi) { const int t0 = 16 * (wid * NMT + mi) + 4 * q;
    u32x2 w; w.x = pk2(acc[mi][0], acc[mi][1]); w.y = pk2(acc[mi][2], acc[mi][3]);
    *reinterpret_cast<u32x2*>(YTc + (long)i * RPB + t0) = w; }
  __syncthreads();
}

constexpr int NWAVES = 8;
constexpr size_t MiB = 1u << 20;
constexpr size_t WS_CTL = 0, CTL_ZERO_BYTES = 64 * 1024;
constexpr size_t WS_WIN = 1 * MiB;
constexpr size_t WS_WOUT = WS_WIN + 72 * MiB;
constexpr size_t WS_WUP = WS_WOUT + 32 * MiB;
constexpr size_t WS_WDN = WS_WUP + 128 * MiB;
constexpr size_t WS_MODV = WS_WDN + 128 * MiB;
constexpr size_t WS_ROPED = WS_MODV + 4 * MiB;
constexpr size_t WS_ROPEG = WS_ROPED + 1 * MiB;
constexpr size_t WS_KFL = WS_ROPEG + 1 * MiB;
constexpr size_t WS_KFC = WS_KFL + 16 * MiB;
constexpr size_t WS_XS = WS_KFC + 2 * MiB;
constexpr size_t WS_XN = WS_XS + 144 * MiB;
constexpr size_t WS_H = WS_XN + 144 * MiB;
constexpr size_t WS_YB = WS_H + 128 * MiB;
constexpr size_t WS_CAT = WS_H + 324 * MiB;
constexpr size_t WS_X0 = WS_CAT + 144 * MiB;
constexpr size_t WS_ZT = WS_X0 + 36 * MiB;
constexpr size_t WS_YT = WS_ZT + 36 * MiB;
constexpr size_t WS_HIDR = WS_YT + 36 * MiB;
constexpr size_t WS_END = WS_HIDR + 64 * MiB;
constexpr int CW_BAR = 4096;

constexpr int SCR_BYTES = 139264;
constexpr int LDSCTL_OFF = SCR_BYTES, MISC_OFF = LDSCTL_OFF + 320;
constexpr int LDS_BYTES = 147456;
static_assert(MISC_OFF + 128 <= WTAB_OFF && WTAB_OFF + 256 <= LDS_BYTES, "LDS map");

typedef GAS unsigned gu32;
#define RLX_AGENT __ATOMIC_RELAXED, __HIP_MEMORY_SCOPE_AGENT
#define LDS_WAIT() asm volatile("s_waitcnt lgkmcnt(0)" ::: "memory")

#define XB_TMO      128
#define XB_XCNT(j)  (256  + 64 * (j))
#define XB_XSUB(j)  (1280 + 64 * (j))
#define XB_XGEN(j)  (2304 + 64 * (j))
#define XB_TOP      3328
#define XB_TOPGEN   3392
#define XCD_BAR_WORDS 3456
#define XB_SPIN_CAP (1u << 18)

__device__ __forceinline__ unsigned xb_ld(unsigned* p)              { return __hip_atomic_load(p, __ATOMIC_RELAXED, __HIP_MEMORY_SCOPE_AGENT); }
__device__ __forceinline__ unsigned xb_add(unsigned* p, unsigned v) { return __hip_atomic_fetch_add(p, v, __ATOMIC_RELAXED, __HIP_MEMORY_SCOPE_AGENT); }
__device__ __forceinline__ unsigned xb_xcc_id() { return (unsigned)__builtin_amdgcn_s_getreg((3 << 11) | 20) & 0xFu; }
#define XB_SPIN(cond, bar) do { unsigned _sp = 0; while (cond) { __builtin_amdgcn_s_sleep(1); \
    if ((++_sp & 255u) == 0u) { if (xb_ld(&(bar)[XB_TMO])) break; if (_sp > XB_SPIN_CAP) { atomicAdd(&(bar)[XB_TMO], 1u); break; } } } } while (0)

struct XcdBarrier {
    unsigned* bar; unsigned x;
    volatile LAS unsigned* st;
};

__device__ __forceinline__ XcdBarrier xcd_barrier_post(unsigned* bar, volatile LAS unsigned* st) {
    XcdBarrier b; b.bar = bar; b.x = xb_xcc_id(); b.st = st;
    if (ktid() == 0) st[2] = xb_add(&bar[XB_XCNT(b.x)], 1u);
    return b;
}
__device__ __forceinline__ void xcd_barrier_complete(unsigned* bar, unsigned x, unsigned& nloc, unsigned& nx) {
    const unsigned G = gridDim.x * gridDim.y * gridDim.z;
    unsigned sum, cnt, mine, sp = 0u;
    for (;;) {
        sum = 0u; cnt = 0u; mine = 0u;
#pragma unroll
        for (unsigned j = 0; j < 16; ++j) { const unsigned c = xb_ld(&bar[XB_XCNT(j)]); sum += c; cnt += (c > 0u) ? 1u : 0u; mine = (j == x) ? c : mine; }
        if (sum == G) break;
        __builtin_amdgcn_s_sleep(1);
        if ((++sp & 255u) == 0u) { if (xb_ld(&bar[XB_TMO])) break; if (sp > XB_SPIN_CAP) { atomicAdd(&bar[XB_TMO], 1u); break; } }
    }
    nloc = mine > 0u ? mine : 1u; nx = cnt > 0u ? cnt : 1u;
}

__device__ __forceinline__ void xcd_barrier(const XcdBarrier& b) {
    asm volatile("s_waitcnt vmcnt(0)" ::: "memory");
    __syncthreads();
    if (ktid() == 0) {
        unsigned* bar = b.bar;
        __builtin_amdgcn_s_waitcnt(0);
        unsigned nloc = b.st[0], nx = b.st[1];
        if (nloc == 0u) { xcd_barrier_complete(bar, b.x, nloc, nx); b.st[0] = nloc; b.st[1] = nx; }
        const unsigned old = xb_add(&bar[XB_XSUB(b.x)], 1u);
        const unsigned gen = old / nloc;
        if (old + 1u == (gen + 1u) * nloc) {
            __builtin_amdgcn_fence(__ATOMIC_RELEASE, "agent");
            asm volatile("s_waitcnt vmcnt(0)" ::: "memory");
            const unsigned og = xb_add(&bar[XB_TOP], 1u);
            const unsigned tg = og / nx;
            if (og + 1u == (tg + 1u) * nx) xb_add(&bar[XB_TOPGEN], 1u);
            else XB_SPIN(xb_ld(&bar[XB_TOPGEN]) == tg, bar);
            __builtin_amdgcn_fence(__ATOMIC_ACQUIRE, "agent");
            xb_add(&bar[XB_XGEN(b.x)], 1u);
            asm volatile("s_waitcnt vmcnt(0)" ::: "memory");
        } else {
            XB_SPIN(xb_ld(&bar[XB_XGEN(b.x)]) == gen, bar);
            __builtin_amdgcn_fence(__ATOMIC_ACQUIRE, "agent");
            asm volatile("s_waitcnt vmcnt(0)" ::: "memory");
        }
    }
    __syncthreads();
}

#define XB_LSUB(j)  (3520 + 64 * (j))
#define XB_LGEN(j)  (4608 + 64 * (j))
__device__ __forceinline__ void xcd_local_barrier(const XcdBarrier& b, unsigned nloc) {
    asm volatile("s_waitcnt vmcnt(0)" ::: "memory");
    __syncthreads();
    if (ktid() == 0) { unsigned* bar = b.bar;
        const unsigned old = xb_add(&bar[XB_LSUB(b.x)], 1u), gen = old / nloc;
        if (old + 1u == (gen + 1u) * nloc) xb_add(&bar[XB_LGEN(b.x)], 1u);
        else XB_SPIN(xb_ld(&bar[XB_LGEN(b.x)]) == gen, bar);
        __builtin_amdgcn_fence(__ATOMIC_ACQUIRE, "agent"); asm volatile("s_waitcnt vmcnt(0)" ::: "memory"); }
    __syncthreads();
}
__device__ __forceinline__ void g1_mid_barrier(unsigned* barw, unsigned x) { XcdBarrier b; b.bar = barw; b.x = x; b.st = nullptr; xcd_local_barrier(b, 32u); }
#define XB_L2SUB(j)  (5184 + 64 * (j))
#define XB_L2GEN(j)  (5760 + 64 * (j))
__device__ __forceinline__ void xcd_sub_barrier(const XcdBarrier& b, unsigned nsub) {
    asm volatile("s_waitcnt vmcnt(0)" ::: "memory");
    __syncthreads();
    if (ktid() == 0) { unsigned* bar = b.bar;
        const unsigned old = xb_add(&bar[XB_L2SUB(b.x)], 1u), gen = old / nsub;
        if (old + 1u == (gen + 1u) * nsub) xb_add(&bar[XB_L2GEN(b.x)], 1u);
        else XB_SPIN(xb_ld(&bar[XB_L2GEN(b.x)]) == gen, bar);
        __builtin_amdgcn_fence(__ATOMIC_ACQUIRE, "agent"); asm volatile("s_waitcnt vmcnt(0)" ::: "memory"); }
    __syncthreads();
}
struct Args { const void* in[28]; float* out; unsigned char* ws; int ph_lo, ph_hi; };
enum { I_X = 0, I_C, I_CTX, I_CCTX, I_WMOD, I_BMOD, I_GNORM, I_WIN, I_WOUT, I_DLAM, I_DSUBLN, I_GQN, I_GKN, I_GON, I_HCW, I_HCB, I_HW1, I_HB1, I_HW2, I_HB2, I_HW3, I_HB3, I_HWOUT, I_HFREQ, I_HBIAS, I_HON, I_WUP, I_WDN };

DI void p0_transpose_item(const float* __restrict__ W, int K, int N, u16* __restrict__ WT, LAS float* scr, int item, int lane) {
    const int nblk = N / 64, kb = item / nblk, nb = item - kb * nblk, k0 = 64 * kb, n0 = 64 * nb;
    const int kr = lane >> 4, nc = lane & 15;
    f32x4 v[16];
#pragma unroll
    for (int i = 0; i < 16; ++i) v[i] = __builtin_nontemporal_load((const f32x4*)(W + (size_t)(k0 + 4 * i + kr) * N + n0 + 4 * nc));
#pragma unroll
    for (int i = 0; i < 16; ++i) { LAS float* s = scr + (4 * i + kr) * 65 + 4 * nc; s[0] = v[i].x; s[1] = v[i].y; s[2] = v[i].z; s[3] = v[i].w; }
    LDS_WAIT(); asm volatile("" ::: "memory");
    const int nr = lane >> 3, kc = lane & 7;
#pragma unroll
    for (int it = 0; it < 8; ++it) { const int n = 8 * it + nr; const LAS float* s = scr + (8 * kc) * 65 + n;
        u32x4 o; o.x = pk2(s[0 * 65], s[1 * 65]); o.y = pk2(s[2 * 65], s[3 * 65]); o.z = pk2(s[4 * 65], s[5 * 65]); o.w = pk2(s[6 * 65], s[7 * 65]);
        __builtin_nontemporal_store(o, (u32x4*)(WT + (size_t)(n0 + n) * K + k0 + 8 * kc)); }
    LDS_WAIT(); asm volatile("" ::: "memory");
}
DI void p0_weights(const Args& a, LAS unsigned char* lds, int vcu, int G, int l_lo, int l_hi) {
    const int tid = opaque_tid(), lane = tid & 63, wave = __builtin_amdgcn_readfirstlane(tid >> 6), gw = vcu * NWAVES + wave, NGW = G * NWAVES;
    LAS float* scr = (LAS float*)(lds + wave * 16640);
    constexpr int I_IN = (DM / 64) * (NIN / 64), I_OUT = (DM / 64) * (DM / 64), I_UP = (DM / 64) * (DFF / 64), I_DN = (DFF / 64) * (DM / 64), PER = I_IN + I_OUT + I_UP + I_DN;
    for (int it = gw; it < (l_hi - l_lo) * PER; it += NGW) {
        const int l = l_lo + it / PER; int r = it - (l - l_lo) * PER;
        if (r < I_IN) { p0_transpose_item((const float*)a.in[I_WIN] + (size_t)l * DM * NIN, DM, NIN, (u16*)(a.ws + WS_WIN) + (size_t)l * NIN * DM, scr, r, lane); continue; } r -= I_IN;
        if (r < I_OUT) { p0_transpose_item((const float*)a.in[I_WOUT] + (size_t)l * DM * DM, DM, DM, (u16*)(a.ws + WS_WOUT) + (size_t)l * DM * DM, scr, r, lane); continue; } r -= I_OUT;
        if (r < I_UP) { p0_transpose_item((const float*)a.in[I_WUP] + (size_t)l * DM * DFF, DM, DFF, (u16*)(a.ws + WS_WUP) + (size_t)l * DFF * DM, scr, r, lane); continue; } r -= I_UP;
        p0_transpose_item((const float*)a.in[I_WDN] + (size_t)l * DFF * DM, DFF, DM, (u16*)(a.ws + WS_WDN) + (size_t)l * DM * DFF, scr, r, lane);
    }
}
DI void p0_mod(const Args& a, LAS unsigned char* lds, int blk, int G) {
    const int tid = opaque_tid(), lane = tid & 63, wave = __builtin_amdgcn_readfirstlane(tid >> 6);
    const float* c = (const float*)a.in[I_C]; const float* cc = (const float*)a.in[I_CCTX];
    const float* wmod = (const float*)a.in[I_WMOD]; const float* bmod = (const float*)a.in[I_BMOD]; const float* gn = (const float*)a.in[I_GNORM];
    float* modv = (float*)(a.ws + WS_MODV);
    LAS float* part = (LAS float*)lds;
    const int k0 = wave * 256, li = lane & 31, kg = lane >> 5;
    bf16x8 af[16];
#pragma unroll
    for (int ks = 0; ks < 16; ++ks) { const int k = k0 + 16 * ks + 8 * kg;
        f32x4 x0 = {0.f, 0.f, 0.f, 0.f}, x1 = x0;
        if (li < 17) { const float* sp = (li < 16) ? c + li * DM + k : cc + k; x0 = *(const f32x4*)sp; x1 = *(const f32x4*)(sp + 4); }
        float v[8] = {x0[0], x0[1], x0[2], x0[3], x1[0], x1[1], x1[2], x1[3]};
#pragma unroll
        for (int j = 0; j < 8; ++j) v[j] = v[j] / (1.0f + expf(-v[j]));
        u32x4 w; w.x = pk2(v[0], v[1]); w.y = pk2(v[2], v[3]); w.z = pk2(v[4], v[5]); w.w = pk2(v[6], v[7]); af[ks] = __builtin_bit_cast(bf16x8, w); }
    constexpr unsigned ROWB = NMOD * DM * 4;
    for (int item = blk; item < NLAYER * 192; item += G) {
        const int l = item / 192, nb = item - l * 192, n = 64 * nb + lane;
        const char* wl = (const char*)(wmod + (size_t)l * DM * (NMOD * DM));
        const unsigned voff = (unsigned)(k0 + 8 * kg) * ROWB + (unsigned)(64 * nb + 2 * li) * 4u;
        f32x16 acc0 = {}, acc1 = {};
        float wa[2][16], wb[2][16];
#define MOD_LOADG(buf, g) do { _Pragma("unroll") for (int kk = 0; kk < 2; ++kk) _Pragma("unroll") for (int j = 0; j < 8; ++j) { const char* rp = wl + (size_t)((16 * (2 * (g) + kk) + j)) * ROWB;   \
            const f32x2 v2_ = __builtin_nontemporal_load((const f32x2*)(rp + voff)); buf[0][kk * 8 + j] = v2_.x; buf[1][kk * 8 + j] = v2_.y; } } while (0)
#define MOD_MULG(buf, g) do { _Pragma("unroll") for (int kk = 0; kk < 2; ++kk) { u32x4 b0, b1;                                                                                         \
            b0.x = pk2(buf[0][kk * 8 + 0], buf[0][kk * 8 + 1]); b0.y = pk2(buf[0][kk * 8 + 2], buf[0][kk * 8 + 3]); b0.z = pk2(buf[0][kk * 8 + 4], buf[0][kk * 8 + 5]); b0.w = pk2(buf[0][kk * 8 + 6], buf[0][kk * 8 + 7]); \
            b1.x = pk2(buf[1][kk * 8 + 0], buf[1][kk * 8 + 1]); b1.y = pk2(buf[1][kk * 8 + 2], buf[1][kk * 8 + 3]); b1.z = pk2(buf[1][kk * 8 + 4], buf[1][kk * 8 + 5]); b1.w = pk2(buf[1][kk * 8 + 6], buf[1][kk * 8 + 7]); \
            acc0 = __builtin_amdgcn_mfma_f32_32x32x16_bf16(af[2 * (g) + kk], __builtin_bit_cast(bf16x8, b0), acc0, 0, 0, 0);                                                           \
            acc1 = __builtin_amdgcn_mfma_f32_32x32x16_bf16(af[2 * (g) + kk], __builtin_bit_cast(bf16x8, b1), acc1, 0, 0, 0); } } while (0)
        MOD_LOADG(wa, 0);
#pragma unroll
        for (int g = 0; g < 8; g += 2) {
            MOD_LOADG(wb, g + 1); __builtin_amdgcn_sched_barrier(0);
            MOD_MULG(wa, g); __builtin_amdgcn_sched_barrier(0);
            if (g + 2 < 8) { MOD_LOADG(wa, g + 2); } __builtin_amdgcn_sched_barrier(0);
            MOD_MULG(wb, g + 1); __builtin_amdgcn_sched_barrier(0);
        }
#undef MOD_LOADG
#undef MOD_MULG
#pragma unroll
        for (int r = 0; r < 9; ++r) { const int i = (r & 3) + 8 * (r >> 2) + 4 * kg;
            if (r < 8 || kg == 0) { part[(wave * 17 + i) * 64 + 2 * li] = acc0[r]; part[(wave * 17 + i) * 64 + 2 * li + 1] = acc1[r]; } }
        __syncthreads();
        for (int i = wave; i < 17; i += 8) {
            float s = 0.f;
#pragma unroll
            for (int w = 0; w < 8; ++w) s += part[(w * 17 + i) * 64 + lane];
            s += bmod[l * (NMOD * DM) + n];
            const int chunk = n / DM, col = n - chunk * DM;
            float v = s;
            if (chunk == 1) v = gn[(l * 4 + 0) * DM + col] * (1.0f + s);
            else if (chunk == 2) v = gn[(l * 4 + 1) * DM + col] * s;
            else if (chunk == 4) v = gn[(l * 4 + 2) * DM + col] * (1.0f + s);
            else if (chunk == 5) v = gn[(l * 4 + 3) * DM + col] * s;
            modv[((size_t)(l * 17 + i) * NMOD + chunk) * DM + col] = v;
        }
        __syncthreads();
    }
}
DI void p0_filters(const Args& a, LAS unsigned char* lds, int blk, int G, int l_lo, int l_hi) {
    const int tid = opaque_tid(), lane = tid & 63, wave = __builtin_amdgcn_readfirstlane(tid >> 6);
    const float* w1 = (const float*)a.in[I_HW1]; const float* b1 = (const float*)a.in[I_HB1]; const float* w2 = (const float*)a.in[I_HW2]; const float* b2 = (const float*)a.in[I_HB2];
    const float* w3 = (const float*)a.in[I_HW3]; const float* b3 = (const float*)a.in[I_HB3]; const float* wout = (const float*)a.in[I_HWOUT]; const float* fr = (const float*)a.in[I_HFREQ];
    const float* hbias = (const float*)a.in[I_HBIAS];
    LAS float* hs = (LAS float*)lds;
    for (int it = blk; it < (l_hi - l_lo) * 36; it += G) {
        const int l = l_lo + it / 36; int pbk = it - (l - l_lo) * 36; asm volatile("" : "+s"(pbk));
        const bool isctx = pbk >= 32; const int n = isctx ? CTXL : SEQ, i0 = 64 * (isctx ? pbk - 32 : pbk);
        u16* kf = isctx ? (u16*)(a.ws + WS_KFC) + (size_t)l * 512 * 512 : (u16*)(a.ws + WS_KFL) + (size_t)l * 512 * 4096;
#pragma unroll 1
        for (int p = 0; p < 8; ++p) {
            const int i = i0 + 8 * wave + p; const float rn1 = isctx ? (1.0f / (float)(CTXL - 1)) : (1.0f / (float)(SEQ - 1)), rn = isctx ? (6.283185307179586f / (float)CTXL) : (6.283185307179586f / (float)SEQ);
            const float t = (float)i * rn1, w = (float)i * rn;
            float zk = 0.f;
            if (lane == 0) zk = t;
            else if (lane < 17) { const float f = 1e-4f + (float)(lane - 1) * ((15.0f - 1e-4f) / 15.0f); zk = cosf(f * w); }
            else if (lane < 33) { const float f = 1e-4f + (float)(lane - 17) * ((15.0f - 1e-4f) / 15.0f); zk = -sinf(f * w); }
            float s = b1[l * 64 + lane];
#pragma unroll
            for (int k = 0; k < 33; ++k) s = fmaf(rdlane(zk, k), w1[(l * 33 + k) * 64 + lane], s);
            float h = sinf(fr[(l * 3 + 0) * 64 + lane] * s);
            s = b2[l * 64 + lane];
#pragma unroll 16
            for (int k = 0; k < 64; ++k) s = fmaf(rdlane(h, k), w2[(l * 64 + k) * 64 + lane], s);
            h = sinf(fr[(l * 3 + 1) * 64 + lane] * s);
            s = b3[l * 64 + lane];
#pragma unroll 16
            for (int k = 0; k < 64; ++k) s = fmaf(rdlane(h, k), w3[(l * 64 + k) * 64 + lane], s);
            hs[(8 * wave + p) * 65 + lane] = sinf(fr[(l * 3 + 2) * 64 + lane] * s);
        }
        __syncthreads();
        const int pl = lane & 31, kg = lane >> 5;
        const float rn1o = isctx ? (1.0f / (float)(CTXL - 1)) : (1.0f / (float)(SEQ - 1));
        const float min_decay = -4.605170185988091f / 1.5f, max_decay = -4.605170185988091f / 0.3f;
        bf16x8 bh[2][4], bl[2][4];
#pragma unroll
        for (int bb = 0; bb < 2; ++bb)
#pragma unroll
            for (int ks = 0; ks < 4; ++ks) { const LAS float* hp = hs + (32 * bb + pl) * 65 + 16 * ks + 8 * kg; u32x4 h, lo;
#pragma unroll
                for (int q = 0; q < 4; ++q) { const float x0 = hp[2 * q], x1 = hp[2 * q + 1]; const unsigned w = pk2(x0, x1); h[q] = w; lo[q] = pk2(x0 - bflo(w), x1 - bfhi(w)); }
                bh[bb][ks] = __builtin_bit_cast(bf16x8, h); bl[bb][ks] = __builtin_bit_cast(bf16x8, lo); }
        const bool back = wave >= 4;
#pragma unroll 1
        for (int ab = 0; ab < 4; ++ab) {
            const int cc0 = 128 * wave + 32 * ab;
            bf16x8 ah[4], al[4];
#pragma unroll
            for (int ks = 0; ks < 4; ++ks) { const float* wp = wout + (size_t)(l * 64 + 16 * ks + 8 * kg) * 1024 + cc0 + pl; u32x4 h, lo;
#pragma unroll
                for (int q = 0; q < 4; ++q) { const float x0 = wp[(2 * q) * 1024], x1 = wp[(2 * q + 1) * 1024]; const unsigned w = pk2(x0, x1); h[q] = w; lo[q] = pk2(x0 - bflo(w), x1 - bfhi(w)); }
                ah[ks] = __builtin_bit_cast(bf16x8, h); al[ks] = __builtin_bit_cast(bf16x8, lo); }
#pragma unroll
            for (int bb = 0; bb < 2; ++bb) {
                f32x16 acc = {};
#pragma unroll
                for (int ks = 0; ks < 4; ++ks) { acc = __builtin_amdgcn_mfma_f32_32x32x16_bf16(al[ks], bh[bb][ks], acc, 0, 0, 0); acc = __builtin_amdgcn_mfma_f32_32x32x16_bf16(ah[ks], bl[bb][ks], acc, 0, 0, 0);
                    acc = __builtin_amdgcn_mfma_f32_32x32x16_bf16(ah[ks], bh[bb][ks], acc, 0, 0, 0); }
                const int i = i0 + 32 * bb + pl; const float tt = (float)i * rn1o;
#pragma unroll
                for (int r = 0; r < 16; ++r) { const int cc = cc0 + (r & 3) + 8 * (r >> 2) + 4 * kg, ch = cc & 511;
                    const float ad = fabsf(min_decay + (float)ch * ((max_decay - min_decay) / 511.0f));
                    float v = acc[r] * expf(-tt * ad);
                    u16* kc = kf + (size_t)ch * (2 * n);
                    if (!back) { if (i == 0) v += hbias[l * 512 + ch]; kc[n + i] = tobf(v); }
                    else { if (i == 0) kc[0] = 0; else kc[n - i] = tobf(v); } }
            }
        }
        __syncthreads();
    }
}
DI void p0_rope(const Args& a, int blk, int G) {
    const int gt = blk * (NWAVES * 64) + opaque_tid(), NGT = G * NWAVES * 64;
    f32x2* rd = (f32x2*)(a.ws + WS_ROPED); f32x2* rg = (f32x2*)(a.ws + WS_ROPEG);
    for (int e = gt; e < SEQ * 96; e += NGT) {
        const int t = e / 96, p = e - t * 96; const float trow = (float)(t >> 6), tcol = (float)(t & 63);
        if (p < 32) { const int k = p & 15; const float inv = powf(10000.0f, -(float)(2 * k) / 32.0f), ang = (p < 16 ? trow : tcol) * inv; rd[t * 32 + p] = (f32x2){cosf(ang), sinf(ang)}; }
        else { const int pp = p - 32, k = pp & 31; const float inv = powf(10000.0f, -(float)(2 * k) / 64.0f), ang = (pp < 32 ? trow : tcol) * inv; rg[t * 64 + pp] = (f32x2){cosf(ang), sinf(ang)}; }
    }
}

template <int MODE, bool FROM_IN = false>
DI void tpass(const Args& a, LAS unsigned char* lds, int blk, int G, int l, int lA  , int cA, int cB, bool write_xn, int segmask  , int rb_lo = 0, int rb_hi = 256, bool out_f32 = false, size_t mixoff = WS_YB  , int xr0 = -1  , int xlen = 144) {
    const int tid = opaque_tid(), lane = tid & 63, wave = __builtin_amdgcn_readfirstlane(tid >> 6);
    const float* modv = (const float*)(a.ws + WS_MODV);
    u16* XN = (u16*)(a.ws + WS_XN); const u16* MIX = (const u16*)(a.ws + mixoff); const u16* YY = (const u16*)(a.ws + WS_CAT); u16* XS = (u16*)(a.ws + WS_XS);
    LAS f32x4* Gs = (LAS f32x4*)lds; LAS f32x4* As = (LAS f32x4*)(lds + 8192); LAS f32x4* Bs = (LAS f32x4*)(lds + 16384); LAS f32x4* G2s = (LAS f32x4*)(lds + 24576);
    constexpr bool fin = (MODE == 0) || FROM_IN;
    const int blen = xr0 >= 0 ? xlen : 144;
    for (int rb = xr0 >= 0 ? 0 : rb_lo + blk; rb < (xr0 >= 0 ? 1 : rb_hi); rb += G) {
        const int r0 = xr0 >= 0 ? xr0 : rb * 144, b = r0 / RPB, j0 = r0 - b * RPB;
#pragma unroll 1
        for (int seg = 0; seg < 2; ++seg) {
            const int ja = seg == 0 ? j0 : (j0 > CTXL ? j0 : CTXL), jb = seg == 0 ? (j0 + blen < CTXL ? j0 + blen : CTXL) : j0 + blen;
            if (ja >= jb || !((segmask >> seg) & 1)) continue;
            const int vi = seg == 0 ? 16 : b;
            __syncthreads();
            { const int t = wave * 64 + lane;
              if (MODE != 0) Gs[t] = *(const f32x4*)(modv + ((size_t)(l * 17 + vi) * NMOD + 2) * DM + 4 * t);
              if (MODE == 2) G2s[t] = *(const f32x4*)(modv + ((size_t)(l * 17 + vi) * NMOD + 5) * DM + 4 * t);
              if (write_xn) { As[t] = *(const f32x4*)(modv + ((size_t)(lA * 17 + vi) * NMOD + cA) * DM + 4 * t); Bs[t] = *(const f32x4*)(modv + ((size_t)(lA * 17 + vi) * NMOD + cB) * DM + 4 * t); } }
            __syncthreads();
#define TP_LOAD(jj) do { const unsigned ro_ = (unsigned)((b * RPB + (jj)) * (DM * 2)) + lane * 8u; \
                if (fin) { const char* xb0_ = (jj) < CTXL ? (const char*)a.in[I_CTX] : (const char*)a.in[I_X]; const unsigned xo_ = (unsigned)(((jj) < CTXL ? b * CTXL + (jj) : b * SEQ + ((jj) - CTXL)) * (DM * 4)) + lane * 16u; \
                    _Pragma("unroll") for (int q = 0; q < 8; ++q) xn_[q] = __builtin_nontemporal_load((const f32x4*)(xb0_ + xo_ + q * 1024)); } \
                else { _Pragma("unroll") for (int q = 0; q < 8; ++q) xb_[q] = __builtin_nontemporal_load((const u32x2*)((const char*)XS + ro_ + q * 512)); } \
                if (MODE != 0) { _Pragma("unroll") for (int q = 0; q < 8; ++q) mn_[q] = __builtin_nontemporal_load((const u32x2*)((const char*)MIX + ro_ + q * 512)); } \
                if (MODE == 2) { _Pragma("unroll") for (int q = 0; q < 8; ++q) yn_[q] = __builtin_nontemporal_load((const u32x2*)((const char*)YY + ro_ + q * 512)); } } while (0)
            f32x4 xn_[8]; u32x2 xb_[8]; u32x2 mn_[8]; u32x2 yn_[8];
            if (ja + wave < jb) TP_LOAD(ja + wave);
            for (int j = ja + wave; j < jb; j += NWAVES) {
                asm volatile("" ::: "memory");
                const unsigned ro = (unsigned)((b * RPB + j) * (DM * 2)) + lane * 8u;
                f32x4 xv[8]; u32x2 mw[8]; u32x2 yw[8];
#pragma unroll
                for (int q = 0; q < 8; ++q) { xv[q] = fin ? xn_[q] : (f32x4){bflo(xb_[q].x), bfhi(xb_[q].x), bflo(xb_[q].y), bfhi(xb_[q].y)}; mw[q] = mn_[q]; yw[q] = yn_[q]; }
                if (j + NWAVES < jb) TP_LOAD(j + NWAVES);
                if (MODE != 0) {
                    float ss = 0.f;
#pragma unroll
                    for (int q = 0; q < 8; ++q) { const float m0 = bflo(mw[q].x), m1 = bfhi(mw[q].x), m2 = bflo(mw[q].y), m3 = bfhi(mw[q].y); ss += (m0 * m0 + m1 * m1) + (m2 * m2 + m3 * m3); }
                    const float rs = frsq(wave_sum(ss) * (1.0f / DM) + EPS);
#pragma unroll
                    for (int q = 0; q < 8; ++q) xv[q] = xv[q] + Gs[lane + 64 * q] * (f32x4){bflo(mw[q].x), bfhi(mw[q].x), bflo(mw[q].y), bfhi(mw[q].y)} * rs;
                }
                if (MODE == 2) {
                    float ss = 0.f;
#pragma unroll
                    for (int q = 0; q < 8; ++q) { const float m0 = bflo(yw[q].x), m1 = bfhi(yw[q].x), m2 = bflo(yw[q].y), m3 = bfhi(yw[q].y); ss += (m0 * m0 + m1 * m1) + (m2 * m2 + m3 * m3); }
                    const float rs = frsq(wave_sum(ss) * (1.0f / DM) + EPS);
#pragma unroll
                    for (int q = 0; q < 8; ++q) xv[q] = xv[q] + G2s[lane + 64 * q] * (f32x4){bflo(yw[q].x), bfhi(yw[q].x), bflo(yw[q].y), bfhi(yw[q].y)} * rs;
                    if (out_f32) { const unsigned oo = (unsigned)((b * SEQ + (j - CTXL)) * (DM * 4)) + lane * 16u;
#pragma unroll
                        for (int q = 0; q < 8; ++q) __builtin_nontemporal_store(xv[q], (f32x4*)((char*)a.out + oo + q * 1024)); }
                    else {
#pragma unroll
                        for (int q = 0; q < 8; ++q) { u32x2 w; w.x = pk2(xv[q].x, xv[q].y); w.y = pk2(xv[q].z, xv[q].w); __builtin_nontemporal_store(w, (u32x2*)((char*)XS + ro + q * 512));
                            xv[q] = (f32x4){bflo(w.x), bfhi(w.x), bflo(w.y), bfhi(w.y)}; }
                    }
                }
                if (write_xn) {
                    float ss = 0.f;
#pragma unroll
                    for (int q = 0; q < 8; ++q) ss += (xv[q].x * xv[q].x + xv[q].y * xv[q].y) + (xv[q].z * xv[q].z + xv[q].w * xv[q].w);
                    const float rs = frsq(wave_sum(ss) * (1.0f / DM) + EPS);
#pragma unroll
                    for (int q = 0; q < 8; ++q) { const f32x4 o = xv[q] * rs * As[lane + 64 * q] + Bs[lane + 64 * q];
                        u32x2 w; w.x = pk2(o.x, o.y); w.y = pk2(o.z, o.w); *(u32x2*)((char*)XN + ro + q * 512) = w; }
                }
            }
#undef TP_LOAD
        }
    }
    __syncthreads();
}

DI void t3_hy(const Args& a, int l, LAS unsigned char* lds, int vcu, int G, bool last, int ownx = -1  , int nskip = 0  ) {
    const int tid = opaque_tid(), lane = tid & 63, wave = __builtin_amdgcn_readfirstlane(tid >> 6), gw = vcu * NWAVES + wave, NGW = G * NWAVES;
    const u16* H = (const u16*)(a.ws + WS_H); u16* X0 = (u16*)(a.ws + WS_X0); u16* ZT = (u16*)(a.ws + WS_ZT);
    const float* cw = (const float*)a.in[I_HCW] + (size_t)l * 3 * 1536; const float* cb = (const float*)a.in[I_HCB] + (size_t)l * 1536;
    constexpr int RS = 132;
    LAS unsigned char* tz = lds + wave * (64 * RS);
    const int rr = lane >> 3, ck = lane & 7;
    if (ownx >= 0 && vcu < nskip) return;
    const int it0 = ownx >= 0 ? 576 * ownx + gw - nskip * NWAVES : gw, it1 = ownx >= 0 ? 576 * ownx + 576 : (NROWS / 64) * 8, its = ownx >= 0 ? 256 - nskip * NWAVES : NGW;
    for (int it = it0; it < it1; it += its) {
        const int rt = it >> 3, cgp = it & 7, b = rt / 36, j0 = (rt - b * 36) * 64;
        if (last && j0 < CTXL) continue;
        const int lo = j0 < CTXL ? 0 : CTXL, hiend = j0 < CTXL ? CTXL - 1 : RPB - 1;
        const int c = 64 * cgp + 8 * ck;
        float w[3][3][8], bs[3][8];
#pragma unroll
        for (int set = 0; set < 3; ++set)
#pragma unroll
            for (int e = 0; e < 8; ++e) { const int col = 512 * set + c + e; w[set][0][e] = cw[col]; w[set][1][e] = cw[1536 + col]; w[set][2][e] = cw[3072 + col]; bs[set][e] = cb[col]; }
#pragma unroll 4
        for (int g8 = 0; g8 < 8; ++g8) {
            const int j = j0 + 8 * g8 + rr; const bool hp = j > lo, hn = j < hiend;
            const u16* hr = H + ((size_t)b * RPB + j) * NIN + C_HY + c;
            float u[3][8];
#pragma unroll
            for (int set = 0; set < 3; ++set) {
                const u32x4 wc = *(const u32x4*)(hr + 512 * set);
                u32x4 wp = {0u, 0u, 0u, 0u}, wn = {0u, 0u, 0u, 0u};
                if (hp) wp = *(const u32x4*)(hr - NIN + 512 * set);
                if (hn) wn = *(const u32x4*)(hr + NIN + 512 * set);
#pragma unroll
                for (int e = 0; e < 8; ++e) { const float xp = (e & 1) ? bfhi(wp[e >> 1]) : bflo(wp[e >> 1]), xc = (e & 1) ? bfhi(wc[e >> 1]) : bflo(wc[e >> 1]), xn = (e & 1) ? bfhi(wn[e >> 1]) : bflo(wn[e >> 1]);
                    u[set][e] = w[set][0][e] * xp + w[set][1][e] * xc + w[set][2][e] * xn + bs[set][e]; }
            }
            u32x4 xo; LAS unsigned* pz = (LAS unsigned*)(tz + (8 * g8 + rr) * RS + 16 * ck);
#pragma unroll
            for (int e = 0; e < 4; ++e) { pz[e] = pk2(u[2][2 * e] * u[1][2 * e], u[2][2 * e + 1] * u[1][2 * e + 1]); xo[e] = pk2(u[0][2 * e], u[0][2 * e + 1]); }
            *(u32x4*)(X0 + ((size_t)b * RPB + j) * 512 + c) = xo;
        }
        LDS_WAIT(); asm volatile("" ::: "memory");
        { const int ch4 = lane >> 4, lq = lane & 15;
          const size_t ob = (size_t)b * RPB + j0 + 4 * lq;
#pragma unroll 8
          for (int cc = 0; cc < 64; cc += 4) { const int chl = cc + ch4; const LAS unsigned char* p = tz + (4 * lq) * RS + 2 * chl;
            const unsigned z0 = *(const LAS u16*)(p), z1 = *(const LAS u16*)(p + RS), z2 = *(const LAS u16*)(p + 2 * RS), z3 = *(const LAS u16*)(p + 3 * RS);
            u32x2 zz; zz.x = z0 | (z1 << 16); zz.y = z2 | (z3 << 16);
            *(u32x2*)(ZT + (size_t)(64 * cgp + chl) * NBATCH * RPB + ob) = zz; } }
        LDS_WAIT(); asm volatile("" ::: "memory");
    }
}
DI void t4_hy(const Args& a, int l, LAS unsigned char* lds, int blk, int G, bool last, int ownx = -1  ) {
    const int tid = opaque_tid(), lane = tid & 63, wave = __builtin_amdgcn_readfirstlane(tid >> 6);
    const u16* X0 = (const u16*)(a.ws + WS_X0); const u16* YT = (const u16*)(a.ws + WS_YT); u16* CAT = (u16*)(a.ws + WS_CAT);
    const float* hon = (const float*)a.in[I_HON] + l * 512;
    LAS float* tile = (LAS float*)(lds + wave * (64 * 65 * 4));
    LAS float* part = (LAS float*)(lds + 8 * (64 * 65 * 4));
    const int ch4 = lane >> 4, lq = lane & 15, rr = lane >> 3, ck = lane & 7;
    const int rt0 = ownx >= 0 ? 72 * ownx + blk : blk, rt1 = ownx >= 0 ? 72 * ownx + 72 : NROWS / 64, rts = ownx >= 0 ? 32 : G;
    for (int rt = rt0; rt < rt1; rt += rts) {
        const int b = rt / 36, j0 = (rt - b * 36) * 64;
        if (last && j0 < CTXL) continue;
        u32x4 xw[8];
#pragma unroll
        for (int g8 = 0; g8 < 8; ++g8) xw[g8] = __builtin_nontemporal_load((const u32x4*)(X0 + ((size_t)b * RPB + j0 + 8 * g8 + rr) * 512 + 64 * wave + 8 * ck));
        { const size_t ob = (size_t)b * RPB + j0 + 4 * lq;
#pragma unroll 8
          for (int cc = 0; cc < 64; cc += 4) { const int chl = cc + ch4;
            const u32x2 yw = __builtin_nontemporal_load((const u32x2*)(YT + (size_t)(64 * wave + chl) * NBATCH * RPB + ob));
            LAS float* t = tile + (4 * lq) * 65 + chl; t[0] = bflo(yw.x); t[65] = bfhi(yw.x); t[130] = bflo(yw.y); t[195] = bfhi(yw.y); } }
        LDS_WAIT(); asm volatile("" ::: "memory");
        float o[8][8];
#pragma unroll
        for (int g8 = 0; g8 < 8; ++g8) { const int row = 8 * g8 + rr; const LAS float* t = tile + row * 65 + 8 * ck; float ss = 0.f;
#pragma unroll
            for (int e = 0; e < 8; ++e) { const float x0 = (e & 1) ? bfhi(xw[g8][e >> 1]) : bflo(xw[g8][e >> 1]); const float v = x0 * t[e]; o[g8][e] = v; ss += v * v; }
            ss = sum8(ss);
            if (ck == 0) part[wave * 64 + row] = ss; }
        __syncthreads();
        float hw[8];
#pragma unroll
        for (int e = 0; e < 8; ++e) hw[e] = hon[64 * wave + 8 * ck + e];
#pragma unroll
        for (int g8 = 0; g8 < 8; ++g8) { const int row = 8 * g8 + rr;
            float tot = 0.f;
#pragma unroll
            for (int w = 0; w < 8; ++w) tot += part[w * 64 + row];
            const float rs = frsq(tot * (1.0f / 512.0f) + EPS); u32x4 wv;
#pragma unroll
            for (int e = 0; e < 4; ++e) wv[e] = pk2(o[g8][2 * e] * rs * hw[2 * e], o[g8][2 * e + 1] * rs * hw[2 * e + 1]);
            *(u32x4*)(CAT + ((size_t)b * RPB + j0 + row) * DM + 1536 + 64 * wave + 8 * ck) = wv; }
        __syncthreads();
    }
    __syncthreads();
}
DI void mixer_phase(const Args& a, int l, char* ldsg, int vcu, int G, bool last) {
    const int lane = opaque_tid() & 63;
    const u16* H = (const u16*)(a.ws + WS_H); u16* CAT = (u16*)(a.ws + WS_CAT);
#ifndef MIXMASK
#define MIXMASK 7
#endif
    if (MIXMASK & 1) { const float* gon = (const float*)a.in[I_GON] + l * 128;
      const int nun = last ? 1024 : 1152;
      for (int u = vcu; u < nun; u += G) {
        int b, hq, row0, seq;
        if (u < 1024) { b = u >> 6; hq = ((u >> 5) & 1) * 4 + ((u >> 3) & 3); row0 = b * RPB + CTXL + (u & 7) * 256; seq = RPB; }
        else { const int v = u - 1024; b = v >> 3; hq = v & 7; row0 = b * RPB; seq = CTXL; }
        const int kvh = hq >> 2; const size_t kv0 = (size_t)b * RPB * NIN;
        att::attn_unit<0>(H + (size_t)row0 * NIN + C_GQ + hq * 128, H + kv0 + C_GK + kvh * 128, H + kv0 + C_GV + kvh * 128, seq, ldsg, CAT + (size_t)row0 * DM + 512 + hq * 128, gon, 0.f, 1.f);
      } }
    if (MIXMASK & 2) { const float* dl = (const float*)a.in[I_DLAM] + l * 256; const float* subln = (const float*)a.in[I_DSUBLN] + l * 128;
      const float lam_init = 0.8f - 0.6f * expf(-0.3f * (float)l);
      const float lam = expf(wave_sum(dl[lane] * dl[64 + lane])) - expf(wave_sum(dl[128 + lane] * dl[192 + lane])) + lam_init;
      const int nun = last ? 1024 : 1152;
      for (int u = vcu; u < nun; u += G) {
        int b, h, row0, seq;
        if (u < 1024) { b = u >> 6; h = (u >> 4) & 3; row0 = b * RPB + CTXL + (u & 15) * 128; seq = RPB; }
        else { const int v = u - 1024; b = v >> 3; h = (v >> 1) & 3; row0 = b * RPB + (v & 1) * 128; seq = CTXL; }
        const size_t kv0 = (size_t)b * RPB * NIN;
        att::attn_unit<1>(H + (size_t)row0 * NIN + C_DQ + h * 128, H + kv0 + C_DK + h * 128, H + kv0 + C_DV + h * 128, seq, ldsg, CAT + (size_t)row0 * DM + h * 128, subln, lam, 1.0f - lam_init);
      } }
    if (MIXMASK & 4) { const u16* ZT = (const u16*)(a.ws + WS_ZT); u16* YT = (u16*)(a.ws + WS_YT);
      const u16* KFL = (const u16*)(a.ws + WS_KFL) + (size_t)l * 512 * 4096; const u16* KFC = (const u16*)(a.ws + WS_KFC) + (size_t)l * 512 * 512;
      for (int c = vcu; c < 512; c += G) hyena_unit<SEQ>(KFL + (size_t)c * 4096, ZT + (size_t)c * NBATCH * RPB + CTXL, YT + (size_t)c * NBATCH * RPB + CTXL, ldsg);
      if (!last) {
        const int w0 = (G == 256) ? (vcu >= 128 ? vcu - 128 : 512) : vcu, ws = (G == 256) ? 128 : G;
        for (int c = w0; c < 512; c += ws) hyena_unit<CTXL>(KFC + (size_t)c * 512, ZT + (size_t)c * NBATCH * RPB, YT + (size_t)c * NBATCH * RPB, ldsg); }
    }
}

#ifndef REP_P0
#define REP_P0 1
#endif
#ifndef REP_GEMM
#define REP_GEMM 1
#endif
#ifndef REP_MIX
#define REP_MIX 1
#endif
#ifndef REP_THY
#define REP_THY 1
#endif
#ifndef REP_T12
#define REP_T12 0
#endif
#ifndef REP_BAR
#define REP_BAR 1
#endif
#ifndef REP_W
#define REP_W 1
#endif
#define HOSTED false
#ifndef PHMASK
#define PHMASK 0xffff
#endif
#define EN(x) (((PHMASK) >> (x)) & 1)
constexpr int MLP_CH = 32  , NCHUNK = 5, PPL = 16, NPHASE = 2 + NLAYER * PPL;
__global__ void __launch_bounds__(NWAVES * 64, 2) fwd_kernel(Args args) {
    LAS unsigned char* lds = (LAS unsigned char*)lds_raw;
    volatile LAS unsigned* MISC = (volatile LAS unsigned*)(lds + MISC_OFF);
    const int tid = threadIdx.x;
    const int G = gridDim.x, blk = blockIdx.x;
    const int vcu = (G % 8 == 0) ? (blk % 8) * (G / 8) + blk / 8 : blk;
    gu32* ctl = (gu32*)(args.ws + WS_CTL);
    for (int u = tid; u < (LDS_BYTES - LDSCTL_OFF) / 4; u += NWAVES * 64) ((LAS unsigned*)(lds + LDSCTL_OFF))[u] = 0u;
    __syncthreads();
    if ((tid & 63) == 0) ((volatile LAS unsigned*)(lds + WTAB_OFF))[hw_wave_slot()] = (unsigned)(tid >> 6);
    __syncthreads();
    const bool multi = (args.ph_hi - args.ph_lo) > 1;
    XcdBarrier bar; bar.bar = (unsigned*)(ctl + CW_BAR); bar.x = 0; bar.st = nullptr;
    if (multi) bar = xcd_barrier_post((unsigned*)(ctl + CW_BAR), MISC + 8);
#define PH(k) (args.ph_lo <= (k) && (k) < args.ph_hi)
#define SEAM(k) do { if (PH(k) && PH((k) + 1)) for (int rep_ = 0; rep_ < REP_BAR; ++rep_) xcd_barrier(bar); } while (0)
    u16* const XN = (u16*)(args.ws + WS_XN); u16* const HB = (u16*)(args.ws + WS_H); u16* const CAT = (u16*)(args.ws + WS_CAT); u16* const YB = (u16*)(args.ws + WS_YB);

    if (EN(0) && PH(0)) for (int rep = 0; rep < REP_P0; ++rep) {
        __syncthreads();
        for (int rw = 0; rw < REP_W; ++rw) { __syncthreads(); p0_weights(args, lds, vcu, G, 0, HOSTED ? 1 : NLAYER); }
        __syncthreads();
        p0_mod(args, lds, blk, G);
        __syncthreads();
        p0_filters(args, lds, blk, G, 0, HOSTED ? 1 : NLAYER);
        p0_rope(args, blk, G);
    }
    SEAM(0);
    int cb = blk; bool lsync = false;
    if (multi && G == 256) { unsigned okc = 1u;
#pragma unroll
        for (unsigned j = 0; j < 16; ++j) { const unsigned cj = xb_ld((unsigned*)(ctl + CW_BAR) + XB_XCNT(j)); okc &= (j < 8 ? cj == 32u : cj == 0u) ? 1u : 0u; }
        if (__builtin_amdgcn_readfirstlane(okc)) { lsync = true; cb = __builtin_amdgcn_readfirstlane((int)(MISC[10] * 8u + bar.x)); } }
    size_t hid_off = WS_H, yb_off = WS_YB;
    if (lsync) { const size_t x_ = (size_t)(cb & 7), XB_ = (size_t)4608 * NIN * 2;
        hid_off = WS_H + XB_ * x_ - (4 * x_) * ((size_t)256 * DFF * 2);
        yb_off = WS_H + XB_ * x_ + ((size_t)16 << 20) - (4608 * x_) * ((size_t)DM * 2); }
    const int tb = lsync ? (cb & 7) * 32 + (cb >> 3) : blk;
    if (EN(1) && PH(1)) tpass<0>(args, lds, tb, G, 0, 0, 1, 0, true, 3);
    if (lsync) { if (PH(1) && PH(2)) xcd_local_barrier(bar, 32u); } else SEAM(1);
#pragma unroll 1
    for (int l = 0; l < NLAYER; ++l) {
        const int p0 = 2 + l * PPL; const bool last = (l == NLAYER - 1);
        const int npan = last ? 128 : 144;
        if (EN(2) && PH(p0)) {
            pg8::Gemm g{XN, (const u16*)(args.ws + WS_WIN) + (size_t)l * NIN * DM, NROWS, NIN, DM};
            pg8::PanelSched S; S.so.init(NROWS, NIN, G, lsync ? cb : blk); S.base = 0; S.latent_only = false; S.a_local = false; S.o_local = false; S.deal = lsync ? 6 : 0; const bool mid = lsync && !last; if (mid) { S.midbar = bar.bar; S.midx = bar.x; }
            if (last && G == 256) { S.so.init(128 * 256, NIN, G, lsync ? cb : blk); S.latent_only = true; S.deal = 2; S.ctxown = lsync; if (lsync) { S.midbar = bar.bar; S.midx = bar.x; } }
            pg8::EpiQK E{HB, NIN, (const f32x2*)(args.ws + WS_ROPED), (const f32x2*)(args.ws + WS_ROPEG), (const float*)args.in[I_GQN] + l * 128, (const float*)args.in[I_GKN] + l * 128, (LAS float*)(lds + 131072)};
            pg8::gemm_phase<pg8::EpiQK, pg8::PanelSched, true, true>(lds, g, S, E);
            if (HOSTED && !last && blk >= 32) { __syncthreads(); p0_weights(args, lds, blk - 32, 224, l + 1, l + 2); }
        }
        if (lsync) { if (PH(p0) && PH(p0 + 1) && !((cb >> 3) < (last ? 12 : 4))) xcd_local_barrier(bar, 32u); } else SEAM(p0);
        if (EN(3) && PH(p0 + 1)) { for (int rep = 0; rep < REP_THY; ++rep) { if (lsync) t3_hy(args, l, lds, cb >> 3, G, last, cb & 7, last ? 12 : 4); else t3_hy(args, l, lds, vcu, G, last); } }
        SEAM(p0 + 1);
        if (EN(4) && PH(p0 + 2)) for (int rep = 0; rep < REP_MIX; ++rep) mixer_phase(args, l, (char*)lds_raw, vcu, G, last);
        SEAM(p0 + 2);
        if (EN(5) && PH(p0 + 3)) for (int rep = 0; rep < REP_THY; ++rep) { if (lsync) t4_hy(args, l, lds, cb >> 3, G, last, cb & 7); else t4_hy(args, l, lds, blk, G, last); }
        if (lsync) { if (PH(p0 + 3) && PH(p0 + 4)) xcd_local_barrier(bar, 32u); } else SEAM(p0 + 3);
        if (EN(6) && PH(p0 + 4)) {
            pg8::Gemm g{CAT, (const u16*)(args.ws + WS_WOUT) + (size_t)l * DM * DM, npan * 256, DM, DM};
            pg8::PanelSched S; S.so.init(npan * 256, DM, G, lsync ? cb : blk); S.base = 0; S.latent_only = last; S.a_local = false; S.o_local = false; S.deal = (lsync && !last) ? 5 : 0; if (lsync && !last) { S.midbar = bar.bar; S.midx = bar.x; }
            pg8::EpiStore<0> E{(u16*)(args.ws + yb_off), DM};
            for (int rep = 0; rep < REP_GEMM; ++rep) pg8::gemm_phase<pg8::EpiStore<0>, pg8::PanelSched, true, true>(lds, g, S, E);
            if (HOSTED && !last && blk >= 128) { __syncthreads(); p0_filters(args, lds, blk - 128, 128, l + 1, l + 2); }
        }
        const bool g2mid = lsync && !last;
        if (lsync) { if (PH(p0 + 4) && PH(p0 + 5)) { if (!g2mid || (cb >> 3) >= 16) xcd_local_barrier(bar, 32u); else xcd_sub_barrier(bar, 16u); } } else SEAM(p0 + 4);
        if (EN(7) && PH(p0 + 5)) { int xr0 = -1, xl = 144;
            if (g2mid) { const int x_ = cb & 7, rk_ = cb >> 3; if (rk_ >= 16) { xr0 = 4608 * x_ + 256 * (rk_ - 16); xl = 256; } else { xr0 = 4608 * x_ + 4096 + 32 * rk_; xl = 32; } }
            if (l == 0) tpass<1, true>(args, lds, tb, G, l, l, 4, 3, true, 3, 0, 256, false, yb_off, xr0, xl); else tpass<1>(args, lds, tb, G, l, l, 4, 3, true, last ? 2 : 3, 0, 256, false, yb_off, xr0, xl); }
        if (lsync) { if (PH(p0 + 5) && PH(p0 + 6)) xcd_local_barrier(bar, 32u); } else SEAM(p0 + 5);
#pragma unroll 1
        for (int s = 0; s <= 8; ++s) {
            if (PH(p0 + 6 + s)) {
                int dpb = 0, dnp = 0; bool dR = false;
                if (s == 1) { if (!last) { dpb = 128; dnp = 16; dR = true; } } else if (s >= 2 && (s & 1) == 0) { dpb = 32 * ((s - 2) >> 1); dnp = 32; }
                if (EN(9) && dnp > 0) {
                    pg8::Gemm g{(const u16*)(args.ws + (dR ? WS_HIDR : hid_off)), (const u16*)(args.ws + WS_WDN) + (size_t)l * DM * DFF, dnp * 256, DM, DFF};
                    pg8::PanelSched S; S.so.init(dnp * 256, DM, G, cb); S.base = dpb; S.latent_only = last; S.a_local = true; S.o_local = false; S.deal = 0; S.own = lsync; if (lsync && dR) S.so.wgm = 2;
                    pg8::EpiStore<0> E{CAT, DM};
                    pg8::gemm_phase<pg8::EpiStore<0>, pg8::PanelSched, true, true>(lds, g, S, E);
                }
                int upb = 0, unp = 0, deal = 0; bool uR = false;
                if (s == 0) { if (!last) { upb = 128; unp = 16; uR = true; } } else if (s & 1) { upb = 32 * ((s - 1) >> 1); unp = 32; if (s == 1 && !last && G == 256) deal = 1; }
                if (EN(8) && unp > 0) {
                    pg8::Gemm g{XN, (const u16*)(args.ws + WS_WUP) + (size_t)l * DFF * DM, unp * 256, DFF, DM};
                    pg8::PanelSched S; S.so.init(unp * 256, DFF, G, cb); S.base = upb; S.latent_only = last; S.a_local = false; S.o_local = true; S.deal = deal; S.own = lsync; if (lsync && uR) S.so.wgm = 2;
                    pg8::EpiStore<2> E{(u16*)(args.ws + (uR ? WS_HIDR : hid_off)), DFF};
                    pg8::gemm_phase<pg8::EpiStore<2>, pg8::PanelSched, true, true>(lds, g, S, E);
                }
            }
            if (lsync) { if (!(last && s == 0) && PH(p0 + 6 + s) && PH(p0 + 7 + s)) xcd_local_barrier(bar, 32u); }
            else if (!(last && s == 0)) SEAM(p0 + 6 + s);
        }
        if (EN(10) && PH(p0 + 15)) {
            if (l == 0) tpass<2, true>(args, lds, tb, G, l, l + 1, 1, 0, true, 3, 0, 256, false, yb_off); else tpass<2>(args, lds, tb, G, l, last ? l : l + 1, 1, 0, !last, last ? 2 : 3, 0, 256, last, yb_off); }
        if (lsync && !last) { if (PH(p0 + 15) && PH(p0 + 16)) xcd_local_barrier(bar, 32u); } else SEAM(p0 + 15);
    }
#undef PH
#undef SEAM
}

#ifndef MK_PER_PHASE
#define MK_PER_PHASE 0
#endif
extern "C" void kernel_launch(void* const* d_in, const int* in_sizes, int n_in, void* d_out, int out_size, void* d_ws, size_t ws_size, hipStream_t stream) {
    static int grid = 0;
    if (grid == 0) {
        if (n_in != 28 || in_sizes[0] != NBATCH * SEQ * DM || out_size != NBATCH * SEQ * DM || ws_size < WS_END) {
            fprintf(stderr, "kernel_launch: unexpected shapes: n_in %d in0 %d out %d ws %zu (need >= %zu)\n", n_in, n_in > 0 ? in_sizes[0] : -1, out_size, ws_size, (size_t)WS_END); grid = -1; return; }
        int dev = 0, cus = 0, per_cu = 0;
        if (hipGetDevice(&dev) != hipSuccess || hipDeviceGetAttribute(&cus, hipDeviceAttributeMultiprocessorCount, dev) != hipSuccess) { grid = -1; return; }
        if (hipFuncSetAttribute((const void*)fwd_kernel, hipFuncAttributeMaxDynamicSharedMemorySize, LDS_BYTES) != hipSuccess) { fprintf(stderr, "kernel_launch: hipFuncSetAttribute failed\n"); grid = -1; return; }
        if (hipOccupancyMaxActiveBlocksPerMultiprocessor(&per_cu, (const void*)fwd_kernel, NWAVES * 64, LDS_BYTES) != hipSuccess || per_cu < 1)
            fprintf(stderr, "kernel_launch: note: occupancy query reports %d workgroups per CU\n", per_cu);
        (void)hipGetLastError();
        grid = cus;
    }
    if (grid < 0) return;
    if (hipMemsetAsync((char*)d_ws + WS_CTL, 0, CTL_ZERO_BYTES, stream) != hipSuccess) return;
    Args a{};
    for (int i = 0; i < 28; ++i) a.in[i] = d_in[i];
    a.out = (float*)d_out; a.ws = (unsigned char*)d_ws;
#if MK_PER_PHASE
    for (int p = 0; p < NPHASE; ++p) { a.ph_lo = p; a.ph_hi = p + 1; hipLaunchKernelGGL(fwd_kernel, dim3(grid), dim3(NWAVES * 64), LDS_BYTES, stream, a); }
#else
    a.ph_lo = 0; a.ph_hi = NPHASE;
    hipLaunchKernelGGL(fwd_kernel, dim3(grid), dim3(NWAVES * 64), LDS_BYTES, stream, a);
#endif
    const hipError_t le = hipPeekAtLastError();
    if (le != hipSuccess) fprintf(stderr, "kernel_launch: launch failed: %s\n", hipGetErrorName(le));
}
```

```cpp
#include <hip/hip_runtime.h>
#include <cstdio>
#include <cstdint>

#ifndef PG8_WGM
#define PG8_WGM 4
#endif
#define GAS __attribute__((address_space(1)))
#define LAS __attribute__((address_space(3)))
#define DI __device__ __forceinline__
typedef unsigned short u16;
typedef short bf16x8 __attribute__((ext_vector_type(8)));
typedef short s16x4 __attribute__((ext_vector_type(4)));
typedef float f32x2 __attribute__((ext_vector_type(2)));
typedef float f32x4 __attribute__((ext_vector_type(4)));
typedef float f32x16 __attribute__((ext_vector_type(16)));
typedef unsigned u32x2 __attribute__((ext_vector_type(2)));
typedef unsigned u32x4 __attribute__((ext_vector_type(4)));
typedef __bf16 bf16x2_t __attribute__((ext_vector_type(2)));

constexpr int DM = 2048, NBATCH = 16, SEQ = 2048, CTXL = 256, RPB = SEQ + CTXL  , NROWS = NBATCH * RPB  ;
constexpr int NLAYER = 4, NIN = 4608, DFF = 8192, NMOD = 6;
constexpr int C_DQ = 0, C_GQ = 512, C_HY = 1536, C_DK = 3072, C_DV = 3584, C_GK = 4096, C_GV = 4352;
constexpr float EPS = 1e-6f;

DI unsigned pk2(float lo, float hi) { f32x2 v = {lo, hi}; bf16x2_t b = __builtin_convertvector(v, bf16x2_t); return __builtin_bit_cast(unsigned, b); }
DI float bflo(unsigned w) { return __uint_as_float(w << 16); }
DI float bfhi(unsigned w) { return __uint_as_float(w & 0xffff0000u); }
DI float bf1(u16 h) { return __uint_as_float(((unsigned)h) << 16); }
DI u16 tobf(float v) { return (u16)(pk2(v, 0.f) & 0xffffu); }
template <int CTRL> DI float dppf(float v) { return __builtin_bit_cast(float, __builtin_amdgcn_update_dpp(0, __builtin_bit_cast(int, v), CTRL, 0xf, 0xf, true)); }
DI float sum_rows16(float v) {
    auto t = __builtin_amdgcn_permlane16_swap(__float_as_uint(v), __float_as_uint(v), false, false); return __uint_as_float(t[0]) + __uint_as_float(t[1]); }
DI float sum_halves32(float v) {
    auto t = __builtin_amdgcn_permlane32_swap(__float_as_uint(v), __float_as_uint(v), false, false); return __uint_as_float(t[0]) + __uint_as_float(t[1]); }
DI float sum8(float v) { v += dppf<0xB1>(v); v += dppf<0x4E>(v); v += dppf<0x141>(v); return v; }
DI float sum16(float v) { v = sum8(v); v += dppf<0x140>(v); return v; }
DI float sum32(float v) { return sum_rows16(sum16(v)); }
DI float wave_sum(float v) { return sum_halves32(sum32(v)); }
DI float frsq(float x) { return __builtin_amdgcn_rsqf(x); }
DI float rdlane(float v, int l) { return __builtin_bit_cast(float, __builtin_amdgcn_readlane(__builtin_bit_cast(int, v), l)); }

extern __shared__ __attribute__((aligned(16))) unsigned char lds_raw[];
constexpr int WTAB_OFF = 139776;
DI int hw_wave_slot() { return (int)__builtin_amdgcn_s_getreg((5 << 11) | 4) & 63; }
DI int lane_id() { int l; asm volatile("v_mbcnt_lo_u32_b32 %0, -1, 0\n\tv_mbcnt_hi_u32_b32 %0, -1, %0" : "=v"(l)); return l; }
DI int ktid() { const unsigned w = ((volatile LAS unsigned*)((LAS unsigned char*)lds_raw + WTAB_OFF))[hw_wave_slot()]; return (int)__builtin_amdgcn_readfirstlane(w) * 64 + lane_id(); }
DI int opaque_tid() { int t = ktid(); asm volatile("" : "+v"(t)); return t; }

namespace pg8 {
#define PG8_LAS __attribute__((address_space(3)))
typedef unsigned short bf16_t;
typedef short bf16x8 __attribute__((ext_vector_type(8)));
typedef float f32x4 __attribute__((ext_vector_type(4)));
typedef unsigned u32x4 __attribute__((ext_vector_type(4)));
constexpr int BM = 256, BK = 64, HALF = 128, HTB = HALF * BK * 2  , STAGE_BYTES = 8 * HTB, NXCD = 8, WGM = PG8_WGM;

__host__ __device__ __forceinline__ int lds_byte(int r, int c) { const int st = (r >> 4) * 2 + (c >> 5), rr = r & 15, cc = c & 31, ob = rr * 64 + cc * 2; return st * 1024 + (ob ^ (((ob >> 9) & 1) << 5)); }
__host__ __device__ __forceinline__ void stage_rc(int b, int& R, int& C) { const int st = b / 1024, sb = b % 1024, swz = sb ^ (((sb >> 9) & 1) << 5); R = (st >> 1) * 16 + swz / 64; C = (st & 1) * 32 + (swz % 64) / 2; }
__host__ __device__ __forceinline__ int perm32(int rho) { const int n = rho >> 4, i = rho & 15; return 8 * (i >> 2) + 4 * n + (i & 3); }

struct Unit { int pm, pn, pa, fl; };
struct Gemm { const bf16_t* A; const bf16_t* Bt; int M, N, K; };

struct StaticOrder {
    int nM, nN, nwg, G, c, wgm;
    __host__ __device__ void init(int M, int N, int G_, int c_) { nM = M / BM; nN = N / BM; nwg = nM * nN; G = G_; c = c_; wgm = WGM; }
    __host__ __device__ bool next(int i, Unit& u) const {
        const long L = (long)i * G + c; if (L >= nwg) return false;
        int wgid = (int)L; { const int q = nwg / NXCD, r = nwg % NXCD, xcd = wgid % NXCD, off = wgid / NXCD; wgid = (xcd < r ? xcd * (q + 1) : r * (q + 1) + (xcd - r) * q) + off; }
        const int nig = wgm * nN, gid = wgid / nig, fm = gid * wgm, gsz = (nM - fm) < wgm ? (nM - fm) : wgm;
        u.pm = fm + ((wgid % nig) % gsz); u.pn = (wgid % nig) / gsz; return true;
    }
    __device__ __forceinline__ void a_ready(const Unit&) const {}
    __device__ __forceinline__ void done(const Unit&) const {}
};

template <int ACT  > struct EpiStore {
    static constexpr bool PERM = true, AFTER_DRAIN = false;
    bf16_t* O; int ldc;
    __device__ __forceinline__ void operator()(const f32x4 (&acc)[2][2][4][2], const Unit& u, int wr, int wc, int fr, int fq) const {
        const int row0 = u.pm * BM + wr * 64 + fr; const int col0 = u.pn * BM + wc * 32 + 8 * fq;
#pragma unroll
        for (int ai = 0; ai < 2; ++ai)
#pragma unroll
            for (int m = 0; m < 4; ++m) { bf16_t* rowp = O + (size_t)(row0 + ai * HALF + m * 16) * ldc + col0;
#pragma unroll
                for (int bj = 0; bj < 2; ++bj) { f32x4 v0 = acc[ai][bj][m][0], v1 = acc[ai][bj][m][1];
                    if (ACT == 2) {
#pragma unroll
                        for (int e = 0; e < 4; ++e) { float a, b; asm("v_max_f32_e32 %0, 0, %1" : "=v"(a) : "v"(v0[e])); asm("v_max_f32_e32 %0, 0, %1" : "=v"(b) : "v"(v1[e]));
                            v0[e] = a * a; v1[e] = b * b; } }
                    u32x4 w; w.x = pk2(v0[0], v0[1]); w.y = pk2(v0[2], v0[3]); w.z = pk2(v1[0], v1[1]); w.w = pk2(v1[2], v1[3]);
                    *(u32x4*)(rowp + bj * HALF) = w; } }
    }
};
constexpr float QS_DIFF = 0.125f * 1.4426950408889634f;
struct EpiQK {
    static constexpr bool PERM = true, AFTER_DRAIN = false;
    bf16_t* O; int ldc; const f32x2* rd; const f32x2* rg; const float* qn; const float* kn; PG8_LAS float* scr;
    __device__ __forceinline__ void operator()(const f32x4 (&acc)[2][2][4][2], const Unit& u, int wr, int wc, int fr, int fq) const {
        const int pn = u.pn, pj = u.pm % 9; const bool lat = pj != 0; const int tbase = (pj - 1) * 256;
        const int type = (pn < 2 || pn == 12 || pn == 13) ? 1 : ((pn >= 2 && pn < 6) || pn == 16) ? 2 : 0;
        const int row0 = u.pm * BM + wr * 64 + fr; const int col0 = pn * BM + wc * 32 + 8 * fq;
        float rs[2][4][2];
        float wv[8];
#pragma unroll
        for (int e = 0; e < 8; ++e) wv[e] = 1.f;
        if (type == 2) {
            const float* gw = (pn == 16 ? kn : qn) + wc * 32 + 8 * fq;
#pragma unroll
            for (int e = 0; e < 8; ++e) wv[e] = gw[e];
#pragma unroll
            for (int ai = 0; ai < 2; ++ai)
#pragma unroll
                for (int m = 0; m < 4; ++m)
#pragma unroll
                    for (int bj = 0; bj < 2; ++bj) { const f32x4 a = acc[ai][bj][m][0], b = acc[ai][bj][m][1];
                        float s = (a[0] * a[0] + a[1] * a[1]) + (a[2] * a[2] + a[3] * a[3]) + (b[0] * b[0] + b[1] * b[1]) + (b[2] * b[2] + b[3] * b[3]);
                        s = sum_halves32(sum_rows16(s));
                        if (fq == 0) scr[(((wr * 128 + ai * 64 + m * 16 + fr) * 2) + bj) * 4 + wc] = s; }
            asm volatile("s_waitcnt lgkmcnt(0)" ::: "memory"); __builtin_amdgcn_s_barrier(); asm volatile("" ::: "memory");
#pragma unroll
            for (int ai = 0; ai < 2; ++ai)
#pragma unroll
                for (int m = 0; m < 4; ++m)
#pragma unroll
                    for (int bj = 0; bj < 2; ++bj) { const f32x4 p = *(const PG8_LAS f32x4*)(scr + (((wr * 128 + ai * 64 + m * 16 + fr) * 2) + bj) * 4);
                        rs[ai][m][bj] = frsq(((p[0] + p[1]) + (p[2] + p[3])) * (1.0f / 128.0f) + 1e-6f); }
        } else {
#pragma unroll
            for (int ai = 0; ai < 2; ++ai)
#pragma unroll
                for (int m = 0; m < 4; ++m) { rs[ai][m][0] = 1.f; rs[ai][m][1] = 1.f; }
        }
        const bool rope = lat && type != 0;
        if (type == 0) {
#pragma unroll
            for (int ai = 0; ai < 2; ++ai)
#pragma unroll
                for (int m = 0; m < 4; ++m) { bf16_t* rowp = O + (size_t)(row0 + ai * HALF + m * 16) * ldc + col0;
#pragma unroll
                    for (int bj = 0; bj < 2; ++bj) { const f32x4 v0 = acc[ai][bj][m][0], v1 = acc[ai][bj][m][1];
                        u32x4 w; w.x = pk2(v0[0], v0[1]); w.y = pk2(v0[2], v0[3]); w.z = pk2(v1[0], v1[1]); w.w = pk2(v1[2], v1[3]);
                        *(u32x4*)(rowp + bj * HALF) = w; } }
        } else if (type == 1) {
#pragma unroll
            for (int ai = 0; ai < 2; ++ai)
#pragma unroll
                for (int m = 0; m < 4; ++m) { bf16_t* rowp = O + (size_t)(row0 + ai * HALF + m * 16) * ldc + col0;
                    f32x2 cs[4];
#pragma unroll
                    for (int i = 0; i < 4; ++i) cs[i] = (f32x2){1.f, 0.f};
                    if (rope) { const int t = tbase + ai * HALF + wr * 64 + m * 16 + fr; const unsigned co = (unsigned)(t * 32 + 16 * (wc & 1) + 4 * fq) * 8u;
#pragma unroll
                        for (int i = 0; i < 4; ++i) cs[i] = *(const f32x2*)((const char*)rd + co + 8 * i); }
                    const float qs = pn < 2 ? QS_DIFF : 1.0f;
#pragma unroll
                    for (int bj = 0; bj < 2; ++bj) { const f32x4 v0 = acc[ai][bj][m][0], v1 = acc[ai][bj][m][1];
                        const float x[8] = {v0[0] * qs, v0[1] * qs, v0[2] * qs, v0[3] * qs, v1[0] * qs, v1[1] * qs, v1[2] * qs, v1[3] * qs};
                        u32x4 w;
#pragma unroll
                        for (int i = 0; i < 4; ++i) { const float x0 = x[2 * i], x1 = x[2 * i + 1]; w[i] = pk2(x0 * cs[i].x - x1 * cs[i].y, x0 * cs[i].y + x1 * cs[i].x); }
                        *(u32x4*)(rowp + bj * HALF) = w; } }
        } else {
#pragma unroll
            for (int ai = 0; ai < 2; ++ai)
#pragma unroll
                for (int m = 0; m < 4; ++m) { bf16_t* rowp = O + (size_t)(row0 + ai * HALF + m * 16) * ldc + col0;
                    f32x2 cs[4];
#pragma unroll
                    for (int i = 0; i < 4; ++i) cs[i] = (f32x2){1.f, 0.f};
                    if (rope) { const int t = tbase + ai * HALF + wr * 64 + m * 16 + fr; const unsigned co = (unsigned)(t * 64 + 16 * wc + 4 * fq) * 8u;
#pragma unroll
                        for (int i = 0; i < 4; ++i) cs[i] = *(const f32x2*)((const char*)rg + co + 8 * i); }
#pragma unroll
                    for (int bj = 0; bj < 2; ++bj) { const f32x4 v0 = acc[ai][bj][m][0], v1 = acc[ai][bj][m][1]; const float r_ = rs[ai][m][bj];
                        const float x[8] = {v0[0] * r_ * wv[0], v0[1] * r_ * wv[1], v0[2] * r_ * wv[2], v0[3] * r_ * wv[3], v1[0] * r_ * wv[4], v1[1] * r_ * wv[5], v1[2] * r_ * wv[6], v1[3] * r_ * wv[7]};
                        u32x4 w;
#pragma unroll
                        for (int i = 0; i < 4; ++i) { const float x0 = x[2 * i], x1 = x[2 * i + 1]; w[i] = pk2(x0 * cs[i].x - x1 * cs[i].y, x0 * cs[i].y + x1 * cs[i].x); }
                        *(u32x4*)(rowp + bj * HALF) = w; } }
        }
    }
};
}
__device__ void g1_mid_barrier(unsigned* barw, unsigned x);
namespace pg8 {
struct PanelSched {
    StaticOrder so; int base; bool latent_only, a_local, o_local; int deal; unsigned* midbar = nullptr; unsigned midx = 0; bool own = false, ctxown = false;
    __device__ __forceinline__ bool next(int i, Unit& u) const {
        u.fl = 0;
        if (deal == 0) { if (!so.next(i, u)) return false; }
        else if (deal == 5) {
            const int c = so.c, x = c & 7, uu = 32 * i + (c >> 3); if (uu >= 144) return false;
            const int g = uu >> 5, v = uu & 31;
            if (g < 4) { u.pm = 18 * x + 4 * g + (v & 3); u.pn = v >> 2; } else { u.pm = 18 * x + 16 + (v & 1); u.pn = v >> 1; }
            if (midbar != nullptr && i == 3 && (c >> 3) < 16) u.fl = 1;
            u.pa = u.pm; return true; }
        else if (deal == 6) {
            const int c = so.c, x = c & 7, uu = 32 * i + (c >> 3); if (uu >= 324) return false;
            if (uu < 288) { const int g = uu / 72, v = uu - 72 * g; u.pm = 18 * x + 4 * g + (v & 3); u.pn = v >> 2; } else { const int v = uu - 288; u.pm = 18 * x + 16 + (v & 1); u.pn = v >> 1; }
            if (midbar != nullptr && i == 9 && (c >> 3) < 4) u.fl = 1;
            u.pa = u.pm; return true; }
        else if (deal == 2) {
            if (i < 9) { if (!so.next(i, u)) return false; if (midbar != nullptr && i == 8 && (so.c >> 3) < 12) u.fl = 1; }
            else { const int c = so.c; if (i > 9 || c >= 96) return false;
                if (ctxown) { const int rk = c >> 3; u.pm = 9 * (2 * (c & 7) + rk / 6); u.pn = 12 + rk % 6; }
                else { u.pm = 9 * ((c & 7) + 8 * (c / 48)); u.pn = 12 + ((c >> 3) % 6); }
                u.pa = u.pm; return true; } }
        else { const int c = so.c; int L;
            if (c < 128) { if (i >= 2) return false; L = i * 128 + c; } else { if (i >= 6) return false; L = 256 + i * 128 + (c - 128); }
            StaticOrder t = so; t.G = 0; t.c = L; if (!t.next(0, u)) return false; }
        const int lp = base + u.pm; int act;
        if (own) {
            const int c_ = lp >> 5, r_ = lp & 31;
            if (latent_only) { const int ll = 16 * (r_ >> 2) + 4 * c_ + (r_ & 3); act = (ll >> 3) * 9 + 1 + (ll & 7); }
            else if (lp < 128) act = 18 * (r_ >> 2) + 4 * c_ + (r_ & 3);
            else { const int e_ = lp - 128; act = 18 * (e_ >> 1) + 16 + (e_ & 1); } }
        else act = latent_only ? (lp >> 3) * 9 + 1 + (lp & 7) : lp;
        u.pa = a_local ? u.pm : act; u.pm = o_local ? u.pm : act; return true;
    }
    __device__ __forceinline__ void a_ready(const Unit&) const {}
    __device__ __forceinline__ void done(const Unit& u) const { if (u.fl) g1_mid_barrier(midbar, midx); }
};

template <class Epi, class Sched, bool ALIGN_EPI = false, bool SP2 = false>
__device__ __forceinline__ void gemm_phase(PG8_LAS unsigned char* lds, const Gemm g, const Sched& S, const Epi& E) {
    const int tid = opaque_tid(), wid = __builtin_amdgcn_readfirstlane(tid >> 6), lane = tid & 63, wr = wid >> 2, wc = wid & 3, fr = lane & 15, fq = lane >> 4;
    const int K = g.K, nt = K / BK;
    unsigned voffA[2], voffB[2];
#pragma unroll
    for (int i = 0; i < 2; ++i) { int R, C; stage_rc(tid * 16 + i * 8192, R, C); const int Rb = Epi::PERM ? ((R & ~31) + perm32(R & 31)) : R;
        voffA[i] = (unsigned)(R * K + C) * 2u; voffB[i] = (unsigned)(Rb * K + C) * 2u; }
    const size_t kstep = (size_t)(BK * 2);
    const size_t hstep = (size_t)HALF * K * 2;
    const size_t tstep = 2 * hstep;
    const unsigned ldsw = (unsigned)wid * 1024u;
    const int aoff = lds_byte(wr * 64 + fr, fq * 8), boff = lds_byte(wc * 32 + fr, fq * 8);
#define PG8_SA(b, h) (((b) * 2 + (h)) * HTB)
#define PG8_SB(b, h) ((4 + (b) * 2 + (h)) * HTB)
#define PG8_STAGE(bufoff, gbase, voff) do { _Pragma("unroll") for (int _i = 0; _i < 2; ++_i) \
        __builtin_amdgcn_global_load_lds((const unsigned*)((const char*)(gbase) + (voff)[_i]), (PG8_LAS unsigned*)(lds + (bufoff) + ldsw + _i * 8192), 16, 0, 0); } while (0)
#define PG8_LDA(dst, b, h) do { _Pragma("unroll") for (int m = 0; m < 4; ++m) _Pragma("unroll") for (int k = 0; k < 2; ++k) dst[m][k] = *(const PG8_LAS bf16x8*)(lds + PG8_SA(b, h) + aoff + m * 2048 + k * 1024); } while (0)
#define PG8_LDB(dst, b, h) do { _Pragma("unroll") for (int n = 0; n < 2; ++n) _Pragma("unroll") for (int k = 0; k < 2; ++k) dst[n][k] = *(const PG8_LAS bf16x8*)(lds + PG8_SB(b, h) + boff + n * 2048 + k * 1024); } while (0)
#define PG8_MMA(ai, bj, At, Bt) do { __builtin_amdgcn_s_setprio(1); _Pragma("unroll") for (int m = 0; m < 4; ++m) _Pragma("unroll") for (int n = 0; n < 2; ++n) _Pragma("unroll") for (int k = 0; k < 2; ++k) \
        acc[ai][bj][m][n] = __builtin_amdgcn_mfma_f32_16x16x32_bf16(Bt[n][k], At[m][k], acc[ai][bj][m][n], 0, 0, 0); __builtin_amdgcn_s_setprio(0); } while (0)
#define PG8_WAIT_V(n) asm volatile("s_waitcnt vmcnt(" #n ")" ::: "memory")
#define PG8_WAIT_L(n) asm volatile("s_waitcnt lgkmcnt(" #n ")" ::: "memory")
#define PG8_BAR __builtin_amdgcn_s_barrier()
#define PG8_SCHED __builtin_amdgcn_sched_barrier(0)
    Unit cur, nxt; int ui = 0;
    if (!S.next(0, cur)) return;
    f32x4 acc[2][2][4][2];
#pragma unroll
    for (int a = 0; a < 2; ++a)
#pragma unroll
        for (int b = 0; b < 2; ++b)
#pragma unroll
            for (int m = 0; m < 4; ++m)
#pragma unroll
                for (int n = 0; n < 2; ++n) acc[a][b][m][n] = (f32x4){0.f, 0.f, 0.f, 0.f};
    bf16x8 At[4][2], B0[2][2], B1[2][2];
    const char* cA = (const char*)g.A + (size_t)cur.pa * tstep; const char* cB = (const char*)g.Bt + (size_t)cur.pn * tstep;
    S.a_ready(cur);
    if constexpr (SP2) {
        PG8_STAGE(PG8_SB(0, 0), cB, voffB); PG8_STAGE(PG8_SB(0, 1), cB + hstep, voffB); PG8_STAGE(PG8_SA(0, 0), cA, voffA); PG8_STAGE(PG8_SA(0, 1), cA + hstep, voffA);
        if (wr == 1) PG8_BAR;
        PG8_WAIT_V(2); PG8_BAR;
        PG8_STAGE(PG8_SB(1, 0), cB + kstep, voffB); PG8_STAGE(PG8_SA(1, 0), cA + kstep, voffA); PG8_STAGE(PG8_SB(1, 1), cB + hstep + kstep, voffB);
        PG8_WAIT_V(6); PG8_BAR;
    } else {
        PG8_STAGE(PG8_SB(0, 0), cB, voffB); PG8_STAGE(PG8_SA(0, 0), cA, voffA); PG8_STAGE(PG8_SB(0, 1), cB + hstep, voffB); PG8_STAGE(PG8_SA(0, 1), cA + hstep, voffA);
        if (wr == 1) PG8_BAR;
        PG8_WAIT_V(4); PG8_BAR;
        PG8_STAGE(PG8_SB(1, 0), cB + kstep, voffB); PG8_STAGE(PG8_SA(1, 0), cA + kstep, voffA); PG8_STAGE(PG8_SB(1, 1), cB + hstep + kstep, voffB);
        PG8_WAIT_V(6); PG8_BAR;
    }
    for (;;) {
        const bool has_next = S.next(ui + 1, nxt);
        const char* nA = has_next ? (const char*)g.A + (size_t)nxt.pa * tstep : cA; const char* nB = has_next ? (const char*)g.Bt + (size_t)nxt.pn * tstep : cB;
        for (int t = 0; t < nt; t += 2) {
            const bool last = (t == nt - 2);
            const char* a1 = cA + (size_t)(t + 1) * kstep;
            const char* a2 = last ? nA : cA + (size_t)(t + 2) * kstep; const char* b2 = last ? nB : cB + (size_t)(t + 2) * kstep;
            const char* a3 = a2 + kstep; const char* b3 = b2 + kstep;
            if (last && has_next) S.a_ready(nxt);
            if constexpr (SP2) {
            PG8_LDB(B0, 0, 0); PG8_LDB(B1, 0, 1); PG8_SCHED; PG8_LDA(At, 0, 0); PG8_STAGE(PG8_SA(1, 1), a1 + hstep, voffA);
            PG8_WAIT_V(8); PG8_WAIT_L(0); PG8_BAR; PG8_MMA(0, 0, At, B0); PG8_MMA(0, 1, At, B1); PG8_BAR; PG8_SCHED;
            PG8_LDA(At, 0, 1); PG8_STAGE(PG8_SB(0, 0), b2, voffB); PG8_STAGE(PG8_SB(0, 1), b2 + hstep, voffB); PG8_STAGE(PG8_SA(0, 0), a2, voffA);
            PG8_WAIT_V(8); PG8_WAIT_L(0); PG8_BAR; PG8_MMA(1, 0, At, B0); PG8_MMA(1, 1, At, B1); PG8_BAR; PG8_SCHED;
            PG8_LDB(B0, 1, 0); PG8_LDB(B1, 1, 1); PG8_SCHED; PG8_LDA(At, 1, 0); PG8_STAGE(PG8_SA(0, 1), a2 + hstep, voffA);
            PG8_WAIT_V(8); PG8_WAIT_L(0); PG8_BAR; PG8_MMA(0, 0, At, B0); PG8_MMA(0, 1, At, B1); PG8_BAR; PG8_SCHED;
            PG8_LDA(At, 1, 1); PG8_STAGE(PG8_SB(1, 0), b3, voffB); PG8_STAGE(PG8_SB(1, 1), b3 + hstep, voffB); PG8_STAGE(PG8_SA(1, 0), a3, voffA);
            PG8_WAIT_V(8); PG8_WAIT_L(0); PG8_BAR; PG8_MMA(1, 0, At, B0); PG8_MMA(1, 1, At, B1); PG8_BAR; PG8_SCHED;
            } else {
            PG8_LDB(B0, 0, 0); PG8_SCHED; PG8_LDA(At, 0, 0); PG8_STAGE(PG8_SA(1, 1), a1 + hstep, voffA);
            PG8_WAIT_L(8); PG8_BAR; PG8_WAIT_L(0); PG8_MMA(0, 0, At, B0); PG8_BAR; PG8_SCHED;
            PG8_LDB(B1, 0, 1); PG8_STAGE(PG8_SB(0, 0), b2, voffB);
            PG8_BAR; PG8_WAIT_L(0); PG8_MMA(0, 1, At, B1); PG8_BAR;
            PG8_LDA(At, 0, 1); PG8_STAGE(PG8_SA(0, 0), a2, voffA);
            PG8_BAR; PG8_WAIT_L(0); PG8_MMA(1, 0, At, B0); PG8_BAR; PG8_SCHED;
            PG8_STAGE(PG8_SB(0, 1), b2 + hstep, voffB);
            PG8_WAIT_V(6); PG8_BAR; PG8_MMA(1, 1, At, B1); PG8_BAR;
            PG8_LDB(B0, 1, 0); PG8_SCHED; PG8_LDA(At, 1, 0); PG8_STAGE(PG8_SA(0, 1), a2 + hstep, voffA);
            PG8_WAIT_L(8); PG8_BAR; PG8_WAIT_L(0); PG8_MMA(0, 0, At, B0); PG8_BAR; PG8_SCHED;
            PG8_LDB(B1, 1, 1); PG8_STAGE(PG8_SB(1, 0), b3, voffB);
            PG8_BAR; PG8_WAIT_L(0); PG8_MMA(0, 1, At, B1); PG8_BAR;
            PG8_LDA(At, 1, 1); PG8_STAGE(PG8_SA(1, 0), a3, voffA);
            PG8_BAR; PG8_WAIT_L(0); PG8_MMA(1, 0, At, B0); PG8_BAR; PG8_SCHED;
            PG8_STAGE(PG8_SB(1, 1), b3 + hstep, voffB);
            PG8_WAIT_V(6); PG8_BAR; PG8_MMA(1, 1, At, B1); PG8_BAR;
            }
        }
        if constexpr (ALIGN_EPI) { if (wr == 0) PG8_BAR; }
        if constexpr (!Epi::AFTER_DRAIN) { E(acc, cur, wr, wc, fr, fq); S.done(cur); }
        if (!has_next) break;
#pragma unroll
        for (int a = 0; a < 2; ++a)
#pragma unroll
            for (int b = 0; b < 2; ++b)
#pragma unroll
                for (int m = 0; m < 4; ++m)
#pragma unroll
                    for (int n = 0; n < 2; ++n) acc[a][b][m][n] = (f32x4){0.f, 0.f, 0.f, 0.f};
        cur = nxt; cA = nA; cB = nB; ++ui;
        if constexpr (ALIGN_EPI) { if (wr == 1) PG8_BAR; }
    }
    PG8_WAIT_V(0);
    if constexpr (!ALIGN_EPI) { if (wr == 0) PG8_BAR; }
    PG8_BAR;
    if constexpr (Epi::AFTER_DRAIN) { E.fused(acc, cur, wr, wc, fr, fq, lds, wid, lane); S.done(cur); }
#undef PG8_SA
#undef PG8_SB
#undef PG8_STAGE
#undef PG8_LDA
#undef PG8_LDB
#undef PG8_MMA
#undef PG8_WAIT_V
#undef PG8_WAIT_L
#undef PG8_BAR
#undef PG8_SCHED
}
}
namespace att {
constexpr int NW = 8, QBLK = 32, KVBLK = 64, LDH = NIN;
constexpr float THR = 16.f;
constexpr size_t SHM_V = KVBLK * 128 * 2, SHM_K = KVBLK * 128 * 2, SHM_ATTN = 2 * SHM_V + 2 * SHM_K + NW * 64 * 4;
#define KSWZ(row, colB) ((row) * 256 + ((colB) ^ (((row) & 7) << 4)))
#define SBAR() __builtin_amdgcn_sched_barrier(0)
DI int crow(int r, int hi) { return (r & 3) + 8 * (r >> 2) + 4 * hi; }
DI unsigned cvtpk(float lo, float hi) { unsigned r; asm volatile("v_cvt_pk_bf16_f32 %0, %1, %2" : "=v"(r) : "v"(lo), "v"(hi)); return r; }

DI float max3a(float a, float b, float c) { float d; asm("v_max3_f32 %0, %1, %2, %3" : "=v"(d) : "v"(a), "v"(b), "v"(c)); return d; }
DI float max2a(float a, float b) { float d; asm("v_max_f32_e32 %0, %1, %2" : "=v"(d) : "v"(a), "v"(b)); return d; }
DI float maxchain(float m, const f32x16& p) {
  asm("v_max3_f32 %0, %0, %1, %2\n\tv_max3_f32 %0, %0, %3, %4\n\tv_max3_f32 %0, %0, %5, %6\n\tv_max3_f32 %0, %0, %7, %8\n\tv_max3_f32 %0, %0, %9, %10\n\tv_max3_f32 %0, %0, %11, %12\n\tv_max3_f32 %0, %0, %13, %14"
      : "+v"(m) : "v"(p[2]), "v"(p[3]), "v"(p[4]), "v"(p[5]), "v"(p[6]), "v"(p[7]), "v"(p[8]), "v"(p[9]), "v"(p[10]), "v"(p[11]), "v"(p[12]), "v"(p[13]), "v"(p[14]), "v"(p[15]));
  return m; }
template <int KB> DI float fmamk(float p, float m) { float d; asm("v_fmamk_f32 %0, %1, %3, %2" : "=v"(d) : "v"(p), "v"(m), "n"(KB)); return d; }
template <int CB>
DI void partialSM(f32x16& p0, f32x16& p1, float& m_reg, float& mn, float& alpha, const float C, const float THRS, const float INF  ) {
  float ma = __builtin_amdgcn_fmed3f(p0[0], p0[1], INF), mb = __builtin_amdgcn_fmed3f(p1[0], p1[1], INF);
  ma = maxchain(ma, p0); mb = maxchain(mb, p1);
  float pmax = max2a(ma, mb);
  { auto rr = __builtin_amdgcn_permlane32_swap(__float_as_uint(pmax), __float_as_uint(pmax), false, false);
    pmax = max2a(__uint_as_float(rr[0]), __uint_as_float(rr[1])); }
  if (__builtin_expect(__all(pmax - m_reg <= THRS), 1)) { mn = m_reg; alpha = 1.f; }
  else { asm volatile("; new row max");
    mn = max2a(m_reg, pmax); alpha = __builtin_amdgcn_exp2f((m_reg - mn) * C); m_reg = mn; }
  const float mnC = -mn * C;
#pragma unroll
  for (int r = 0; r < 16; ++r) p0[r] = fmamk<CB>(p0[r], mnC);
#pragma unroll
  for (int r = 0; r < 16; ++r) p1[r] = fmamk<CB>(p1[r], mnC);
#pragma unroll
  for (int r = 0; r < 16; ++r) p0[r] = __builtin_amdgcn_exp2f(p0[r]);
}
template <bool FIRST>
DI void partialSM2(f32x16& p0, f32x16& p1, f32x16& negm, float& alpha, const float THR2, const float INF) {
  float ma = __builtin_amdgcn_fmed3f(p0[0], p0[1], INF), mb = __builtin_amdgcn_fmed3f(p1[0], p1[1], INF);
  ma = maxchain(ma, p0); mb = maxchain(mb, p1);
  float pmax = max2a(ma, mb);
  { auto rr = __builtin_amdgcn_permlane32_swap(__float_as_uint(pmax), __float_as_uint(pmax), false, false);
    pmax = max2a(__uint_as_float(rr[0]), __uint_as_float(rr[1])); }
  if (!FIRST && __builtin_expect(__all(pmax <= THR2), 1)) { alpha = 1.f; }
  else { if (!FIRST) asm volatile("; new row max");
    const float delta = FIRST ? pmax : max2a(pmax, 0.f);
    alpha = FIRST ? 1.f : __builtin_amdgcn_exp2f(-delta);
    const float nm = negm[0] - delta;
#pragma unroll
    for (int r = 0; r < 16; ++r) { p0[r] -= delta; p1[r] -= delta; negm[r] = nm; } }
#pragma unroll
  for (int r = 0; r < 16; ++r) p0[r] = __builtin_amdgcn_exp2f(p0[r]);
}
DI void finishSM(f32x16& p0, f32x16& p1, float alpha, float& l_reg, bf16x8& pa0, bf16x8& pa1, bf16x8& pa2, bf16x8& pa3) {
#pragma unroll
  for (int r = 0; r < 16; ++r) p1[r] = __builtin_amdgcn_exp2f(p1[r]);
  float ps = 0;
#pragma unroll
  for (int r = 0; r < 16; ++r) ps += p0[r];
#pragma unroll
  for (int r = 0; r < 16; ++r) ps += p1[r];
  { auto rr = __builtin_amdgcn_permlane32_swap(__float_as_uint(ps), __float_as_uint(ps), false, false);
    ps = __uint_as_float(rr[0]) + __uint_as_float(rr[1]); }
  l_reg = l_reg * alpha + ps;
#define PK4(P, BASE, OUT) do { unsigned a0 = cvtpk(P[BASE + 0], P[BASE + 1]), a1 = cvtpk(P[BASE + 2], P[BASE + 3]);   \
    unsigned b0 = cvtpk(P[BASE + 4], P[BASE + 5]), b1 = cvtpk(P[BASE + 6], P[BASE + 7]);                              \
    auto r0 = __builtin_amdgcn_permlane32_swap(a0, b0, false, false); auto r1 = __builtin_amdgcn_permlane32_swap(a1, b1, false, false); \
    u32x4 w = {r0[0], r1[0], r0[1], r1[1]}; OUT = *reinterpret_cast<bf16x8*>(&w); } while (0)
  PK4(p0, 0, pa0); PK4(p0, 8, pa1); PK4(p1, 0, pa2); PK4(p1, 8, pa3);
#undef PK4
}
template <int ND0> DI void qkt(f32x16& p0, f32x16& p1, const char* Ks, const bf16x8* qr, int r32, int hi, int cb0, const f32x16& init) {
  p0 = init; p1 = init;
#pragma unroll
  for (int d0 = 0; d0 < ND0; ++d0) { const int cb = cb0 + (d0 * 16 + hi * 8) * 2;
    const bf16x8 b0 = *reinterpret_cast<const bf16x8*>(Ks + KSWZ(r32, cb));
    const bf16x8 b1 = *reinterpret_cast<const bf16x8*>(Ks + KSWZ(32 + r32, cb));
    p0 = __builtin_amdgcn_mfma_f32_32x32x16_bf16(b0, qr[d0], p0, 0, 0, 0);
    p1 = __builtin_amdgcn_mfma_f32_32x32x16_bf16(b1, qr[d0], p1, 0, 0, 0); }
}
DI int v_st(int k, int c) { const int kk = (k & ~0xC) | ((k & 4) << 1) | ((k & 8) >> 1); return ((kk >> 3) * 4 + (c >> 5)) * 512 + ((kk & 7) * 32 + (c & 31)) * 2; }
DI int v_rd_base(int lane) { return ((lane & 3) << 3) | (((lane >> 2) & 3) << 6) | (((lane >> 4) & 1) << 5) | (((lane >> 5) & 1) << 8); }
constexpr int v_rd_off(int d0, int ks, int half) { return d0 * 512 + ks * 4096 + half * 2048; }
template <int OFF> DI s16x4 tr_read(int vb) {
  s16x4 r; asm volatile("ds_read_b64_tr_b16 %0, %1 offset:%2" : "=&v"(r) : "v"(vb), "i"(OFF) : "memory"); return r;
}
template <int D0> DI void pv_one(f32x16& od, int vb, bf16x8 pa0, bf16x8 pa1, bf16x8 pa2, bf16x8 pa3) {
  const s16x4 l0 = tr_read<v_rd_off(D0, 0, 0)>(vb), h0 = tr_read<v_rd_off(D0, 0, 1)>(vb), l1 = tr_read<v_rd_off(D0, 1, 0)>(vb), h1 = tr_read<v_rd_off(D0, 1, 1)>(vb);
  const s16x4 l2 = tr_read<v_rd_off(D0, 2, 0)>(vb), h2 = tr_read<v_rd_off(D0, 2, 1)>(vb), l3 = tr_read<v_rd_off(D0, 3, 0)>(vb), h3 = tr_read<v_rd_off(D0, 3, 1)>(vb);
  asm volatile("s_waitcnt lgkmcnt(0)" ::: "memory"); SBAR();
#define PK(L, H) (bf16x8){L[0], L[1], L[2], L[3], H[0], H[1], H[2], H[3]}
  od = __builtin_amdgcn_mfma_f32_32x32x16_bf16(pa0, PK(l0, h0), od, 0, 0, 0);
  od = __builtin_amdgcn_mfma_f32_32x32x16_bf16(pa1, PK(l1, h1), od, 0, 0, 0);
  od = __builtin_amdgcn_mfma_f32_32x32x16_bf16(pa2, PK(l2, h2), od, 0, 0, 0);
  od = __builtin_amdgcn_mfma_f32_32x32x16_bf16(pa3, PK(l3, h3), od, 0, 0, 0);
#undef PK
}
DI void pv_d0(f32x16* o, int vb, bf16x8 pa0, bf16x8 pa1, bf16x8 pa2, bf16x8 pa3) {
  pv_one<0>(o[0], vb, pa0, pa1, pa2, pa3); pv_one<1>(o[1], vb, pa0, pa1, pa2, pa3); pv_one<2>(o[2], vb, pa0, pa1, pa2, pa3); pv_one<3>(o[3], vb, pa0, pa1, pa2, pa3);
}

template <int MODE>
DI void attn_unit(const u16* __restrict__ Qb, const u16* __restrict__ Kh, const u16* __restrict__ Vh, int seq, char* lds,
                  u16* __restrict__ Ob, const float* __restrict__ gvec, float lam, float post) {
  constexpr int ND0 = MODE ? 4 : 8;
  constexpr float SCALE = MODE ? 0.125f : 0.088388347648318440f;
  constexpr float C = SCALE * 1.4426950408889634f, THRS = THR / SCALE; constexpr int CB = __builtin_bit_cast(int, C); constexpr float THR2 = THR * 1.4426950408889634f;
  int tid_ = ktid(); asm volatile("" : "+v"(tid_));
  const int tid = tid_, wid = __builtin_amdgcn_readfirstlane(tid >> 6), lane = tid & 63, r32 = lane & 31, hi = lane >> 5;
  int infb_ = 0x7f800000; asm("" : "+s"(infb_)); const float INF = __int_as_float(infb_);
  const int wq = MODE ? (wid & 3) : wid, mp = MODE ? (wid >> 2) : 0;
  char* V_lds = lds; char* K_lds = lds + 2 * SHM_V;
  float* ws = (float*)(lds + 2 * SHM_V + 2 * SHM_K) + wid * 64; float* li_l = ws; float* al_l = ws + 32;
  float m_reg = -1e30f, l_reg = 0; f32x16 o[4] = {}; f32x16 negm = {}; bf16x8 qr[ND0];
  const u16* Qw = Qb + (long)(wq * QBLK + r32) * LDH + mp * 64 + hi * 8;
#pragma unroll
  for (int d0 = 0; d0 < ND0; ++d0) qr[d0] = *reinterpret_cast<const bf16x8*>(Qw + d0 * 16);
  const int cb0 = mp * 128;
  const int sr = tid >> 4, sc = (tid & 15) * 8, vst0 = v_st(sr, sc), vst1 = v_st(32 + sr, sc);
  const int vb0 = (int)(uintptr_t)V_lds + v_rd_base(lane);
  struct { bf16x8 vs0, vs1, ks0, ks1; } sr_[2];
#define SLOAD(i, k0) do { sr_[i].vs0 = *reinterpret_cast<const bf16x8*>(&Vh[(long)((k0) + sr) * LDH + sc]); sr_[i].vs1 = *reinterpret_cast<const bf16x8*>(&Vh[(long)((k0) + 32 + sr) * LDH + sc]); \
    sr_[i].ks0 = *reinterpret_cast<const bf16x8*>(&Kh[(long)((k0) + sr) * LDH + sc]); sr_[i].ks1 = *reinterpret_cast<const bf16x8*>(&Kh[(long)((k0) + 32 + sr) * LDH + sc]); } while (0)
#define SWRITE(b, i) do { *(bf16x8*)(V_lds + (b) * SHM_V + vst0) = sr_[i].vs0;          \
    *(bf16x8*)(V_lds + (b) * SHM_V + vst1) = sr_[i].vs1; const int kc = sc * 2;               \
    *(bf16x8*)(K_lds + (b) * SHM_K + KSWZ(sr, kc)) = sr_[i].ks0;                       \
    *(bf16x8*)(K_lds + (b) * SHM_K + KSWZ(32 + sr, kc)) = sr_[i].ks1; } while (0)
#define SWAIT() asm volatile("s_waitcnt vmcnt(4)" ::: "memory")
#define RESC(a) do { if (__any((a) < 1.f)) { if (hi == 0) al_l[r32] = (a); asm volatile("s_waitcnt lgkmcnt(0)" ::: "memory"); \
    _Pragma("unroll") for (int d = 0; d < 4; ++d) _Pragma("unroll") for (int r = 0; r < 16; ++r) o[d][r] *= al_l[crow(r, hi)]; } } while (0)
#define PSM(FIRST, p0, p1, mn, al) do { if constexpr (MODE != 0) partialSM2<FIRST>(p0, p1, negm, al, THR2, INF); else partialSM<CB>(p0, p1, m_reg, mn, al, C, THRS, INF); } while (0)
  f32x16 pA0, pA1, pB0, pB1; float mnA, mnB, alA, alB; bf16x8 pa0, pa1, pa2, pa3; const int NT = seq / KVBLK;
  constexpr int SE = 0, SO = 1;
  SLOAD(SE, 0); asm volatile("s_waitcnt vmcnt(0)" ::: "memory"); SWRITE(0, SE); __syncthreads();
  qkt<ND0>(pA0, pA1, K_lds, qr, r32, hi, cb0, negm); PSM(true, pA0, pA1, mnA, alA);
  SLOAD(SO, KVBLK); if (2 < NT) SLOAD(SE, 2 * KVBLK);
  SWAIT(); SWRITE(1, SO); __syncthreads();
  for (int j = 1; j + 1 < NT; j += 2) {
    SBAR(); qkt<ND0>(pB0, pB1, K_lds + SHM_K, qr, r32, hi, cb0, negm);
    finishSM(pA0, pA1, alA, l_reg, pa0, pa1, pa2, pa3); SBAR();
    SLOAD(SO, (j + 2) * KVBLK); SBAR();
    pv_d0(o, vb0, pa0, pa1, pa2, pa3); PSM(false, pB0, pB1, mnB, alB);
    __syncthreads(); SWAIT(); SWRITE(0, SE);
    RESC(alB); __syncthreads();
    SBAR(); qkt<ND0>(pA0, pA1, K_lds, qr, r32, hi, cb0, negm);
    finishSM(pB0, pB1, alB, l_reg, pa0, pa1, pa2, pa3); SBAR();
    if (j + 3 < NT) SLOAD(SE, (j + 3) * KVBLK); SBAR();
    pv_d0(o, vb0 + (int)SHM_V, pa0, pa1, pa2, pa3); PSM(false, pA0, pA1, mnA, alA);
    __syncthreads(); SWAIT(); SWRITE(1, SO);
    RESC(alA); __syncthreads();
  }
  SBAR(); qkt<ND0>(pB0, pB1, K_lds + SHM_K, qr, r32, hi, cb0, negm);
  finishSM(pA0, pA1, alA, l_reg, pa0, pa1, pa2, pa3); SBAR();
  pv_d0(o, vb0, pa0, pa1, pa2, pa3); PSM(false, pB0, pB1, mnB, alB);
  __syncthreads(); RESC(alB);
  finishSM(pB0, pB1, alB, l_reg, pa0, pa1, pa2, pa3); SBAR();
  pv_d0(o, vb0 + (int)SHM_V, pa0, pa1, pa2, pa3);
  if (hi == 0) li_l[r32] = l_reg; asm volatile("s_waitcnt lgkmcnt(0)" ::: "memory");
  float rli[16];
#pragma unroll
  for (int r = 0; r < 16; ++r) rli[r] = __builtin_amdgcn_rcpf(li_l[crow(r, hi)]);
#pragma unroll
  for (int d0 = 0; d0 < 4; ++d0)
#pragma unroll
    for (int r = 0; r < 16; ++r) o[d0][r] *= rli[r];
  if (MODE) {
    __syncthreads();
    float* ex = (float*)lds + (wq * 64) * 64 + lane;
    if (mp == 1) {
#pragma unroll
      for (int d0 = 0; d0 < 4; ++d0)
#pragma unroll
        for (int r = 0; r < 16; ++r) ex[(d0 * 16 + r) * 64] = o[d0][r];
    }
    __syncthreads();
    if (mp == 0) {
#pragma unroll
      for (int d0 = 0; d0 < 4; ++d0)
#pragma unroll
        for (int r = 0; r < 16; ++r) o[d0][r] -= lam * ex[(d0 * 16 + r) * 64];
    }
  }
  if (mp == 0) {
    float gw[4];
#pragma unroll
    for (int d0 = 0; d0 < 4; ++d0) gw[d0] = gvec[d0 * 32 + r32] * post;
    u16* Ow = Ob + (long)(wq * QBLK) * DM;
#pragma unroll
    for (int r = 0; r < 16; ++r) {
      float s = 0.f;
#pragma unroll
      for (int d0 = 0; d0 < 4; ++d0) s += o[d0][r] * o[d0][r];
      s = sum32(s);
      const float rs = frsq(s * (1.0f / 128.0f) + EPS);
      const int orow = crow(r, hi);
#pragma unroll
      for (int d0 = 0; d0 < 4; ++d0) Ow[(long)orow * DM + d0 * 32 + r32] = tobf(o[d0][r] * rs * gw[d0]);
    }
  }
  __syncthreads();
#undef SLOAD
#undef SWRITE
#undef SWAIT
#undef RESC
#undef PSM
}
#undef SBAR
}

template <int N>
DI void hyena_unit(const u16* __restrict__ KFc, const u16* __restrict__ ZTc, u16* __restrict__ YTc, char* ldsg) {
  constexpr int CL = 2 * N + 8, CS = CL * 2 + 16;
  constexpr int BS = N * 2 + 16;
  constexpr int BOFF = 8 * CS;
  constexpr int NMT = N / 128;
  LAS char* lds = (LAS char*)ldsg;
  int tid_ = ktid(); asm volatile("" : "+v"(tid_));
  const int tid = tid_, wid = __builtin_amdgcn_readfirstlane(tid >> 6), lane = tid & 63;
  for (int e = tid; e < 2 * N / 8; e += 512) { const bf16x8 v = *reinterpret_cast<const bf16x8*>(KFc + 8 * e);
#pragma unroll
    for (int jj = 0; jj < 8; ++jj) { const int y = 2 * N - (8 * e + jj);
#pragma unroll
      for (int r = 0; r < 8; ++r) *(LAS u16*)(lds + r * CS + 2 * (y + r)) = (u16)v[jj]; } }
  for (int e = tid; e < 16 * (N / 8); e += 512) { const int b = e / (N / 8), ch = e - b * (N / 8);
    *(LAS bf16x8*)(lds + BOFF + b * BS + 16 * ch) = *reinterpret_cast<const bf16x8*>(ZTc + (long)b * RPB + 8 * ch); }
  __syncthreads();
  const int i = lane & 15, q = lane >> 4, r = i & 7;
  const int abase = r * CS + 2 * (N - (i - r) + 8 * q) - 32 * (wid * NMT);
  const int bbase = BOFF + i * BS + 16 * q;
  f32x4 acc[NMT];
#pragma unroll
  for (int mi = 0; mi < NMT; ++mi) acc[mi] = (f32x4){0.f, 0.f, 0.f, 0.f};
  bf16x8 F[NMT];
#pragma unroll
  for (int mi = 2; mi < NMT; ++mi) F[(NMT - mi) % NMT] = *(const LAS bf16x8*)(lds + abase - 32 * mi);
  constexpr int UNR = NMT / 2;
  for (int kt0 = 0; kt0 < N / 32; kt0 += UNR) {
#pragma unroll
    for (int kk = 0; kk < UNR; ++kk) { const int kt = kt0 + kk;
      F[(2 * kk + NMT - 1) % NMT] = *(const LAS bf16x8*)(lds + abase + 32 * (2 * kt - 1));
      F[(2 * kk) % NMT] = *(const LAS bf16x8*)(lds + abase + 32 * (2 * kt));
      const bf16x8 bf = *(const LAS bf16x8*)(lds + bbase + 64 * kt);
#pragma unroll
      for (int mi = NMT - 1; mi >= 0; --mi) acc[mi] = __builtin_amdgcn_mfma_f32_16x16x32_bf16(F[(2 * kk - mi + 2 * NMT) % NMT], bf, acc[mi], 0, 0, 0);
    }
  }
#pragma unroll
  for (int mi = 0; mi < NMT; ++mi) { const int t0 = 16 * (wid * NMT + mi) + 4 * q;
    u32x2 w; w.x = pk2(acc[mi][0], acc[mi][1]); w.y = pk2(acc[mi][2], acc[mi][3]);
    *reinterpret_cast<u32x2*>(YTc + (long)i * RPB + t0) = w; }
  __syncthreads();
}

constexpr int NWAVES = 8;
constexpr size_t MiB = 1u << 20;
constexpr size_t WS_CTL = 0, CTL_ZERO_BYTES = 64 * 1024;
constexpr size_t WS_WIN = 1 * MiB;
constexpr size_t WS_WOUT = WS_WIN + 72 * MiB;
constexpr size_t WS_WUP = WS_WOUT + 32 * MiB;
constexpr size_t WS_WDN = WS_WUP + 128 * MiB;
constexpr size_t WS_MODV = WS_WDN + 128 * MiB;
constexpr size_t WS_ROPED = WS_MODV + 4 * MiB;
constexpr size_t WS_ROPEG = WS_ROPED + 1 * MiB;
constexpr size_t WS_KFL = WS_ROPEG + 1 * MiB;
constexpr size_t WS_KFC = WS_KFL + 16 * MiB;
constexpr size_t WS_XS = WS_KFC + 2 * MiB;
constexpr size_t WS_XN = WS_XS + 144 * MiB;
constexpr size_t WS_H = WS_XN + 144 * MiB;
constexpr size_t WS_YB = WS_H + 128 * MiB;
constexpr size_t WS_CAT = WS_H + 324 * MiB;
constexpr size_t WS_X0 = WS_CAT + 144 * MiB;
constexpr size_t WS_ZT = WS_X0 + 36 * MiB;
constexpr size_t WS_YT = WS_ZT + 36 * MiB;
constexpr size_t WS_HIDR = WS_YT + 36 * MiB;
constexpr size_t WS_END = WS_HIDR + 64 * MiB;
constexpr int CW_BAR = 4096;

constexpr int SCR_BYTES = 139264;
constexpr int LDSCTL_OFF = SCR_BYTES, MISC_OFF = LDSCTL_OFF + 320;
constexpr int LDS_BYTES = 147456;
static_assert(MISC_OFF + 128 <= WTAB_OFF && WTAB_OFF + 256 <= LDS_BYTES, "LDS map");

typedef GAS unsigned gu32;
#define RLX_AGENT __ATOMIC_RELAXED, __HIP_MEMORY_SCOPE_AGENT
#define LDS_WAIT() asm volatile("s_waitcnt lgkmcnt(0)" ::: "memory")

#define XB_TMO      128
#define XB_XCNT(j)  (256  + 64 * (j))
#define XB_XSUB(j)  (1280 + 64 * (j))
#define XB_XGEN(j)  (2304 + 64 * (j))
#define XB_TOP      3328
#define XB_TOPGEN   3392
#define XCD_BAR_WORDS 3456
#define XB_SPIN_CAP (1u << 18)

__device__ __forceinline__ unsigned xb_ld(unsigned* p)              { return __hip_atomic_load(p, __ATOMIC_RELAXED, __HIP_MEMORY_SCOPE_AGENT); }
__device__ __forceinline__ unsigned xb_add(unsigned* p, unsigned v) { return __hip_atomic_fetch_add(p, v, __ATOMIC_RELAXED, __HIP_MEMORY_SCOPE_AGENT); }
__device__ __forceinline__ unsigned xb_xcc_id() { return (unsigned)__builtin_amdgcn_s_getreg((3 << 11) | 20) & 0xFu; }
#define XB_SPIN(cond, bar) do { unsigned _sp = 0; while (cond) { __builtin_amdgcn_s_sleep(1); \
    if ((++_sp & 255u) == 0u) { if (xb_ld(&(bar)[XB_TMO])) break; if (_sp > XB_SPIN_CAP) { atomicAdd(&(bar)[XB_TMO], 1u); break; } } } } while (0)

struct XcdBarrier {
    unsigned* bar; unsigned x;
    volatile LAS unsigned* st;
};

__device__ __forceinline__ XcdBarrier xcd_barrier_post(unsigned* bar, volatile LAS unsigned* st) {
    XcdBarrier b; b.bar = bar; b.x = xb_xcc_id(); b.st = st;
    if (ktid() == 0) st[2] = xb_add(&bar[XB_XCNT(b.x)], 1u);
    return b;
}
__device__ __forceinline__ void xcd_barrier_complete(unsigned* bar, unsigned x, unsigned& nloc, unsigned& nx) {
    const unsigned G = gridDim.x * gridDim.y * gridDim.z;
    unsigned sum, cnt, mine, sp = 0u;
    for (;;) {
        sum = 0u; cnt = 0u; mine = 0u;
#pragma unroll
        for (unsigned j = 0; j < 16; ++j) { const unsigned c = xb_ld(&bar[XB_XCNT(j)]); sum += c; cnt += (c > 0u) ? 1u : 0u; mine = (j == x) ? c : mine; }
        if (sum == G) break;
        __builtin_amdgcn_s_sleep(1);
        if ((++sp & 255u) == 0u) { if (xb_ld(&bar[XB_TMO])) break; if (sp > XB_SPIN_CAP) { atomicAdd(&bar[XB_TMO], 1u); break; } }
    }
    nloc = mine > 0u ? mine : 1u; nx = cnt > 0u ? cnt : 1u;
}

__device__ __forceinline__ void xcd_barrier(const XcdBarrier& b) {
    asm volatile("s_waitcnt vmcnt(0)" ::: "memory");
    __syncthreads();
    if (ktid() == 0) {
        unsigned* bar = b.bar;
        __builtin_amdgcn_s_waitcnt(0);
        unsigned nloc = b.st[0], nx = b.st[1];
        if (nloc == 0u) { xcd_barrier_complete(bar, b.x, nloc, nx); b.st[0] = nloc; b.st[1] = nx; }
        const unsigned old = xb_add(&bar[XB_XSUB(b.x)], 1u);
        const unsigned gen = old / nloc;
        if (old + 1u == (gen + 1u) * nloc) {
            __builtin_amdgcn_fence(__ATOMIC_RELEASE, "agent");
            asm volatile("s_waitcnt vmcnt(0)" ::: "memory");
            const unsigned og = xb_add(&bar[XB_TOP], 1u);
            const unsigned tg = og / nx;
            if (og + 1u == (tg + 1u) * nx) xb_add(&bar[XB_TOPGEN], 1u);
            else XB_SPIN(xb_ld(&bar[XB_TOPGEN]) == tg, bar);
            __builtin_amdgcn_fence(__ATOMIC_ACQUIRE, "agent");
            xb_add(&bar[XB_XGEN(b.x)], 1u);
            asm volatile("s_waitcnt vmcnt(0)" ::: "memory");
        } else {
            XB_SPIN(xb_ld(&bar[XB_XGEN(b.x)]) == gen, bar);
            __builtin_amdgcn_fence(__ATOMIC_ACQUIRE, "agent");
            asm volatile("s_waitcnt vmcnt(0)" ::: "memory");
        }
    }
    __syncthreads();
}

#define XB_LSUB(j)  (3520 + 64 * (j))
#define XB_LGEN(j)  (4608 + 64 * (j))
__device__ __forceinline__ void xcd_local_barrier(const XcdBarrier& b, unsigned nloc) {
    asm volatile("s_waitcnt vmcnt(0)" ::: "memory");
    __syncthreads();
    if (ktid() == 0) { unsigned* bar = b.bar;
        const unsigned old = xb_add(&bar[XB_LSUB(b.x)], 1u), gen = old / nloc;
        if (old + 1u == (gen + 1u) * nloc) xb_add(&bar[XB_LGEN(b.x)], 1u);
        else XB_SPIN(xb_ld(&bar[XB_LGEN(b.x)]) == gen, bar);
        __builtin_amdgcn_fence(__ATOMIC_ACQUIRE, "agent"); asm volatile("s_waitcnt vmcnt(0)" ::: "memory"); }
    __syncthreads();
}
__device__ __forceinline__ void g1_mid_barrier(unsigned* barw, unsigned x) { XcdBarrier b; b.bar = barw; b.x = x; b.st = nullptr; xcd_local_barrier(b, 32u); }
#define XB_L2SUB(j)  (5184 + 64 * (j))
#define XB_L2GEN(j)  (5760 + 64 * (j))
__device__ __forceinline__ void xcd_sub_barrier(const XcdBarrier& b, unsigned nsub) {
    asm volatile("s_waitcnt vmcnt(0)" ::: "memory");
    __syncthreads();
    if (ktid() == 0) { unsigned* bar = b.bar;
        const unsigned old = xb_add(&bar[XB_L2SUB(b.x)], 1u), gen = old / nsub;
        if (old + 1u == (gen + 1u) * nsub) xb_add(&bar[XB_L2GEN(b.x)], 1u);
        else XB_SPIN(xb_ld(&bar[XB_L2GEN(b.x)]) == gen, bar);
        __builtin_amdgcn_fence(__ATOMIC_ACQUIRE, "agent"); asm volatile("s_waitcnt vmcnt(0)" ::: "memory"); }
    __syncthreads();
}
struct Args { const void* in[28]; float* out; unsigned char* ws; int ph_lo, ph_hi; };
enum { I_X = 0, I_C, I_CTX, I_CCTX, I_WMOD, I_BMOD, I_GNORM, I_WIN, I_WOUT, I_DLAM, I_DSUBLN, I_GQN, I_GKN, I_GON, I_HCW, I_HCB, I_HW1, I_HB1, I_HW2, I_HB2, I_HW3, I_HB3, I_HWOUT, I_HFREQ, I_HBIAS, I_HON, I_WUP, I_WDN };

DI void p0_transpose_item(const float* __restrict__ W, int K, int N, u16* __restrict__ WT, LAS float* scr, int item, int lane) {
    const int nblk = N / 64, kb = item / nblk, nb = item - kb * nblk, k0 = 64 * kb, n0 = 64 * nb;
    const int kr = lane >> 4, nc = lane & 15;
    f32x4 v[16];
#pragma unroll
    for (int i = 0; i < 16; ++i) v[i] = __builtin_nontemporal_load((const f32x4*)(W + (size_t)(k0 + 4 * i + kr) * N + n0 + 4 * nc));
#pragma unroll
    for (int i = 0; i < 16; ++i) { LAS float* s = scr + (4 * i + kr) * 65 + 4 * nc; s[0] = v[i].x; s[1] = v[i].y; s[2] = v[i].z; s[3] = v[i].w; }
    LDS_WAIT(); asm volatile("" ::: "memory");
    const int nr = lane >> 3, kc = lane & 7;
#pragma unroll
    for (int it = 0; it < 8; ++it) { const int n = 8 * it + nr; const LAS float* s = scr + (8 * kc) * 65 + n;
        u32x4 o; o.x = pk2(s[0 * 65], s[1 * 65]); o.y = pk2(s[2 * 65], s[3 * 65]); o.z = pk2(s[4 * 65], s[5 * 65]); o.w = pk2(s[6 * 65], s[7 * 65]);
        __builtin_nontemporal_store(o, (u32x4*)(WT + (size_t)(n0 + n) * K + k0 + 8 * kc)); }
    LDS_WAIT(); asm volatile("" ::: "memory");
}
DI void p0_weights(const Args& a, LAS unsigned char* lds, int vcu, int G, int l_lo, int l_hi) {
    const int tid = opaque_tid(), lane = tid & 63, wave = __builtin_amdgcn_readfirstlane(tid >> 6), gw = vcu * NWAVES + wave, NGW = G * NWAVES;
    LAS float* scr = (LAS float*)(lds + wave * 16640);
    constexpr int I_IN = (DM / 64) * (NIN / 64), I_OUT = (DM / 64) * (DM / 64), I_UP = (DM / 64) * (DFF / 64), I_DN = (DFF / 64) * (DM / 64), PER = I_IN + I_OUT + I_UP + I_DN;
    for (int it = gw; it < (l_hi - l_lo) * PER; it += NGW) {
        const int l = l_lo + it / PER; int r = it - (l - l_lo) * PER;
        if (r < I_IN) { p0_transpose_item((const float*)a.in[I_WIN] + (size_t)l * DM * NIN, DM, NIN, (u16*)(a.ws + WS_WIN) + (size_t)l * NIN * DM, scr, r, lane); continue; } r -= I_IN;
        if (r < I_OUT) { p0_transpose_item((const float*)a.in[I_WOUT] + (size_t)l * DM * DM, DM, DM, (u16*)(a.ws + WS_WOUT) + (size_t)l * DM * DM, scr, r, lane); continue; } r -= I_OUT;
        if (r < I_UP) { p0_transpose_item((const float*)a.in[I_WUP] + (size_t)l * DM * DFF, DM, DFF, (u16*)(a.ws + WS_WUP) + (size_t)l * DFF * DM, scr, r, lane); continue; } r -= I_UP;
        p0_transpose_item((const float*)a.in[I_WDN] + (size_t)l * DFF * DM, DFF, DM, (u16*)(a.ws + WS_WDN) + (size_t)l * DM * DFF, scr, r, lane);
    }
}
DI void p0_mod(const Args& a, LAS unsigned char* lds, int blk, int G) {
    const int tid = opaque_tid(), lane = tid & 63, wave = __builtin_amdgcn_readfirstlane(tid >> 6);
    const float* c = (const float*)a.in[I_C]; const float* cc = (const float*)a.in[I_CCTX];
    const float* wmod = (const float*)a.in[I_WMOD]; const float* bmod = (const float*)a.in[I_BMOD]; const float* gn = (const float*)a.in[I_GNORM];
    float* modv = (float*)(a.ws + WS_MODV);
    LAS float* part = (LAS float*)lds;
    const int k0 = wave * 256, li = lane & 31, kg = lane >> 5;
    bf16x8 af[16];
#pragma unroll
    for (int ks = 0; ks < 16; ++ks) { const int k = k0 + 16 * ks + 8 * kg;
        f32x4 x0 = {0.f, 0.f, 0.f, 0.f}, x1 = x0;
        if (li < 17) { const float* sp = (li < 16) ? c + li * DM + k : cc + k; x0 = *(const f32x4*)sp; x1 = *(const f32x4*)(sp + 4); }
        float v[8] = {x0[0], x0[1], x0[2], x0[3], x1[0], x1[1], x1[2], x1[3]};
#pragma unroll
        for (int j = 0; j < 8; ++j) v[j] = v[j] / (1.0f + expf(-v[j]));
        u32x4 w; w.x = pk2(v[0], v[1]); w.y = pk2(v[2], v[3]); w.z = pk2(v[4], v[5]); w.w = pk2(v[6], v[7]); af[ks] = __builtin_bit_cast(bf16x8, w); }
    constexpr unsigned ROWB = NMOD * DM * 4;
    for (int item = blk; item < NLAYER * 192; item += G) {
        const int l = item / 192, nb = item - l * 192, n = 64 * nb + lane;
        const char* wl = (const char*)(wmod + (size_t)l * DM * (NMOD * DM));
        const unsigned voff = (unsigned)(k0 + 8 * kg) * ROWB + (unsigned)(64 * nb + 2 * li) * 4u;
        f32x16 acc0 = {}, acc1 = {};
        float wa[2][16], wb[2][16];
#define MOD_LOADG(buf, g) do { _Pragma("unroll") for (int kk = 0; kk < 2; ++kk) _Pragma("unroll") for (int j = 0; j < 8; ++j) { const char* rp = wl + (size_t)((16 * (2 * (g) + kk) + j)) * ROWB;   \
            const f32x2 v2_ = __builtin_nontemporal_load((const f32x2*)(rp + voff)); buf[0][kk * 8 + j] = v2_.x; buf[1][kk * 8 + j] = v2_.y; } } while (0)
#define MOD_MULG(buf, g) do { _Pragma("unroll") for (int kk = 0; kk < 2; ++kk) { u32x4 b0, b1;                                                                                         \
            b0.x = pk2(buf[0][kk * 8 + 0], buf[0][kk * 8 + 1]); b0.y = pk2(buf[0][kk * 8 + 2], buf[0][kk * 8 + 3]); b0.z = pk2(buf[0][kk * 8 + 4], buf[0][kk * 8 + 5]); b0.w = pk2(buf[0][kk * 8 + 6], buf[0][kk * 8 + 7]); \
            b1.x = pk2(buf[1][kk * 8 + 0], buf[1][kk * 8 + 1]); b1.y = pk2(buf[1][kk * 8 + 2], buf[1][kk * 8 + 3]); b1.z = pk2(buf[1][kk * 8 + 4], buf[1][kk * 8 + 5]); b1.w = pk2(buf[1][kk * 8 + 6], buf[1][kk * 8 + 7]); \
            acc0 = __builtin_amdgcn_mfma_f32_32x32x16_bf16(af[2 * (g) + kk], __builtin_bit_cast(bf16x8, b0), acc0, 0, 0, 0);                                                           \
            acc1 = __builtin_amdgcn_mfma_f32_32x32x16_bf16(af[2 * (g) + kk], __builtin_bit_cast(bf16x8, b1), acc1, 0, 0, 0); } } while (0)
        MOD_LOADG(wa, 0);
#pragma unroll
        for (int g = 0; g < 8; g += 2) {
            MOD_LOADG(wb, g + 1); __builtin_amdgcn_sched_barrier(0);
            MOD_MULG(wa, g); __builtin_amdgcn_sched_barrier(0);
            if (g + 2 < 8) { MOD_LOADG(wa, g + 2); } __builtin_amdgcn_sched_barrier(0);
            MOD_MULG(wb, g + 1); __builtin_amdgcn_sched_barrier(0);
        }
#undef MOD_LOADG
#undef MOD_MULG
#pragma unroll
        for (int r = 0; r < 9; ++r) { const int i = (r & 3) + 8 * (r >> 2) + 4 * kg;
            if (r < 8 || kg == 0) { part[(wave * 17 + i) * 64 + 2 * li] = acc0[r]; part[(wave * 17 + i) * 64 + 2 * li + 1] = acc1[r]; } }
        __syncthreads();
        for (int i = wave; i < 17; i += 8) {
            float s = 0.f;
#pragma unroll
            for (int w = 0; w < 8; ++w) s += part[(w * 17 + i) * 64 + lane];
            s += bmod[l * (NMOD * DM) + n];
            const int chunk = n / DM, col = n - chunk * DM;
            float v = s;
            if (chunk == 1) v = gn[(l * 4 + 0) * DM + col] * (1.0f + s);
            else if (chunk == 2) v = gn[(l * 4 + 1) * DM + col] * s;
            else if (chunk == 4) v = gn[(l * 4 + 2) * DM + col] * (1.0f + s);
            else if (chunk == 5) v = gn[(l * 4 + 3) * DM + col] * s;
            modv[((size_t)(l * 17 + i) * NMOD + chunk) * DM + col] = v;
        }
        __syncthreads();
    }
}
DI void p0_filters(const Args& a, LAS unsigned char* lds, int blk, int G, int l_lo, int l_hi) {
    const int tid = opaque_tid(), lane = tid & 63, wave = __builtin_amdgcn_readfirstlane(tid >> 6);
    const float* w1 = (const float*)a.in[I_HW1]; const float* b1 = (const float*)a.in[I_HB1]; const float* w2 = (const float*)a.in[I_HW2]; const float* b2 = (const float*)a.in[I_HB2];
    const float* w3 = (const float*)a.in[I_HW3]; const float* b3 = (const float*)a.in[I_HB3]; const float* wout = (const float*)a.in[I_HWOUT]; const float* fr = (const float*)a.in[I_HFREQ];
    const float* hbias = (const float*)a.in[I_HBIAS];
    LAS float* hs = (LAS float*)lds;
    for (int it = blk; it < (l_hi - l_lo) * 36; it += G) {
        const int l = l_lo + it / 36; int pbk = it - (l - l_lo) * 36; asm volatile("" : "+s"(pbk));
        const bool isctx = pbk >= 32; const int n = isctx ? CTXL : SEQ, i0 = 64 * (isctx ? pbk - 32 : pbk);
        u16* kf = isctx ? (u16*)(a.ws + WS_KFC) + (size_t)l * 512 * 512 : (u16*)(a.ws + WS_KFL) + (size_t)l * 512 * 4096;
#pragma unroll 1
        for (int p = 0; p < 8; ++p) {
            const int i = i0 + 8 * wave + p; const float rn1 = isctx ? (1.0f / (float)(CTXL - 1)) : (1.0f / (float)(SEQ - 1)), rn = isctx ? (6.283185307179586f / (float)CTXL) : (6.283185307179586f / (float)SEQ);
            const float t = (float)i * rn1, w = (float)i * rn;
            float zk = 0.f;
            if (lane == 0) zk = t;
            else if (lane < 17) { const float f = 1e-4f + (float)(lane - 1) * ((15.0f - 1e-4f) / 15.0f); zk = cosf(f * w); }
            else if (lane < 33) { const float f = 1e-4f + (float)(lane - 17) * ((15.0f - 1e-4f) / 15.0f); zk = -sinf(f * w); }
            float s = b1[l * 64 + lane];
#pragma unroll
            for (int k = 0; k < 33; ++k) s = fmaf(rdlane(zk, k), w1[(l * 33 + k) * 64 + lane], s);
            float h = sinf(fr[(l * 3 + 0) * 64 + lane] * s);
            s = b2[l * 64 + lane];
#pragma unroll 16
            for (int k = 0; k < 64; ++k) s = fmaf(rdlane(h, k), w2[(l * 64 + k) * 64 + lane], s);
            h = sinf(fr[(l * 3 + 1) * 64 + lane] * s);
            s = b3[l * 64 + lane];
#pragma unroll 16
            for (int k = 0; k < 64; ++k) s = fmaf(rdlane(h, k), w3[(l * 64 + k) * 64 + lane], s);
            hs[(8 * wave + p) * 65 + lane] = sinf(fr[(l * 3 + 2) * 64 + lane] * s);
        }
        __syncthreads();
        const int pl = lane & 31, kg = lane >> 5;
        const float rn1o = isctx ? (1.0f / (float)(CTXL - 1)) : (1.0f / (float)(SEQ - 1));
        const float min_decay = -4.605170185988091f / 1.5f, max_decay = -4.605170185988091f / 0.3f;
        bf16x8 bh[2][4], bl[2][4];
#pragma unroll
        for (int bb = 0; bb < 2; ++bb)
#pragma unroll
            for (int ks = 0; ks < 4; ++ks) { const LAS float* hp = hs + (32 * bb + pl) * 65 + 16 * ks + 8 * kg; u32x4 h, lo;
#pragma unroll
                for (int q = 0; q < 4; ++q) { const float x0 = hp[2 * q], x1 = hp[2 * q + 1]; const unsigned w = pk2(x0, x1); h[q] = w; lo[q] = pk2(x0 - bflo(w), x1 - bfhi(w)); }
                bh[bb][ks] = __builtin_bit_cast(bf16x8, h); bl[bb][ks] = __builtin_bit_cast(bf16x8, lo); }
        const bool back = wave >= 4;
#pragma unroll 1
        for (int ab = 0; ab < 4; ++ab) {
            const int cc0 = 128 * wave + 32 * ab;
            bf16x8 ah[4], al[4];
#pragma unroll
            for (int ks = 0; ks < 4; ++ks) { const float* wp = wout + (size_t)(l * 64 + 16 * ks + 8 * kg) * 1024 + cc0 + pl; u32x4 h, lo;
#pragma unroll
                for (int q = 0; q < 4; ++q) { const float x0 = wp[(2 * q) * 1024], x1 = wp[(2 * q + 1) * 1024]; const unsigned w = pk2(x0, x1); h[q] = w; lo[q] = pk2(x0 - bflo(w), x1 - bfhi(w)); }
                ah[ks] = __builtin_bit_cast(bf16x8, h); al[ks] = __builtin_bit_cast(bf16x8, lo); }
#pragma unroll
            for (int bb = 0; bb < 2; ++bb) {
                f32x16 acc = {};
#pragma unroll
                for (int ks = 0; ks < 4; ++ks) { acc = __builtin_amdgcn_mfma_f32_32x32x16_bf16(al[ks], bh[bb][ks], acc, 0, 0, 0); acc = __builtin_amdgcn_mfma_f32_32x32x16_bf16(ah[ks], bl[bb][ks], acc, 0, 0, 0);
                    acc = __builtin_amdgcn_mfma_f32_32x32x16_bf16(ah[ks], bh[bb][ks], acc, 0, 0, 0); }
                const int i = i0 + 32 * bb + pl; const float tt = (float)i * rn1o;
#pragma unroll
                for (int r = 0; r < 16; ++r) { const int cc = cc0 + (r & 3) + 8 * (r >> 2) + 4 * kg, ch = cc & 511;
                    const float ad = fabsf(min_decay + (float)ch * ((max_decay - min_decay) / 511.0f));
                    float v = acc[r] * expf(-tt * ad);
                    u16* kc = kf + (size_t)ch * (2 * n);
                    if (!back) { if (i == 0) v += hbias[l * 512 + ch]; kc[n + i] = tobf(v); }
                    else { if (i == 0) kc[0] = 0; else kc[n - i] = tobf(v); } }
            }
        }
        __syncthreads();
    }
}
DI void p0_rope(const Args& a, int blk, int G) {
    const int gt = blk * (NWAVES * 64) + opaque_tid(), NGT = G * NWAVES * 64;
    f32x2* rd = (f32x2*)(a.ws + WS_ROPED); f32x2* rg = (f32x2*)(a.ws + WS_ROPEG);
    for (int e = gt; e < SEQ * 96; e += NGT) {
        const int t = e / 96, p = e - t * 96; const float trow = (float)(t >> 6), tcol = (float)(t & 63);
        if (p < 32) { const int k = p & 15; const float inv = powf(10000.0f, -(float)(2 * k) / 32.0f), ang = (p < 16 ? trow : tcol) * inv; rd[t * 32 + p] = (f32x2){cosf(ang), sinf(ang)}; }
        else { const int pp = p - 32, k = pp & 31; const float inv = powf(10000.0f, -(float)(2 * k) / 64.0f), ang = (pp < 32 ? trow : tcol) * inv; rg[t * 64 + pp] = (f32x2){cosf(ang), sinf(ang)}; }
    }
}

template <int MODE, bool FROM_IN = false>
DI void tpass(const Args& a, LAS unsigned char* lds, int blk, int G, int l, int lA  , int cA, int cB, bool write_xn, int segmask  , int rb_lo = 0, int rb_hi = 256, bool out_f32 = false, size_t mixoff = WS_YB  , int xr0 = -1  , int xlen = 144) {
    const int tid = opaque_tid(), lane = tid & 63, wave = __builtin_amdgcn_readfirstlane(tid >> 6);
    const float* modv = (const float*)(a.ws + WS_MODV);
    u16* XN = (u16*)(a.ws + WS_XN); const u16* MIX = (const u16*)(a.ws + mixoff); const u16* YY = (const u16*)(a.ws + WS_CAT); u16* XS = (u16*)(a.ws + WS_XS);
    LAS f32x4* Gs = (LAS f32x4*)lds; LAS f32x4* As = (LAS f32x4*)(lds + 8192); LAS f32x4* Bs = (LAS f32x4*)(lds + 16384); LAS f32x4* G2s = (LAS f32x4*)(lds + 24576);
    constexpr bool fin = (MODE == 0) || FROM_IN;
    const int blen = xr0 >= 0 ? xlen : 144;
    for (int rb = xr0 >= 0 ? 0 : rb_lo + blk; rb < (xr0 >= 0 ? 1 : rb_hi); rb += G) {
        const int r0 = xr0 >= 0 ? xr0 : rb * 144, b = r0 / RPB, j0 = r0 - b * RPB;
#pragma unroll 1
        for (int seg = 0; seg < 2; ++seg) {
            const int ja = seg == 0 ? j0 : (j0 > CTXL ? j0 : CTXL), jb = seg == 0 ? (j0 + blen < CTXL ? j0 + blen : CTXL) : j0 + blen;
            if (ja >= jb || !((segmask >> seg) & 1)) continue;
            const int vi = seg == 0 ? 16 : b;
            __syncthreads();
            { const int t = wave * 64 + lane;
              if (MODE != 0) Gs[t] = *(const f32x4*)(modv + ((size_t)(l * 17 + vi) * NMOD + 2) * DM + 4 * t);
              if (MODE == 2) G2s[t] = *(const f32x4*)(modv + ((size_t)(l * 17 + vi) * NMOD + 5) * DM + 4 * t);
              if (write_xn) { As[t] = *(const f32x4*)(modv + ((size_t)(lA * 17 + vi) * NMOD + cA) * DM + 4 * t); Bs[t] = *(const f32x4*)(modv + ((size_t)(lA * 17 + vi) * NMOD + cB) * DM + 4 * t); } }
            __syncthreads();
#define TP_LOAD(jj) do { const unsigned ro_ = (unsigned)((b * RPB + (jj)) * (DM * 2)) + lane * 8u; \
                if (fin) { const char* xb0_ = (jj) < CTXL ? (const char*)a.in[I_CTX] : (const char*)a.in[I_X]; const unsigned xo_ = (unsigned)(((jj) < CTXL ? b * CTXL + (jj) : b * SEQ + ((jj) - CTXL)) * (DM * 4)) + lane * 16u; \
                    _Pragma("unroll") for (int q = 0; q < 8; ++q) xn_[q] = __builtin_nontemporal_load((const f32x4*)(xb0_ + xo_ + q * 1024)); } \
                else { _Pragma("unroll") for (int q = 0; q < 8; ++q) xb_[q] = __builtin_nontemporal_load((const u32x2*)((const char*)XS + ro_ + q * 512)); } \
                if (MODE != 0) { _Pragma("unroll") for (int q = 0; q < 8; ++q) mn_[q] = __builtin_nontemporal_load((const u32x2*)((const char*)MIX + ro_ + q * 512)); } \
                if (MODE == 2) { _Pragma("unroll") for (int q = 0; q < 8; ++q) yn_[q] = __builtin_nontemporal_load((const u32x2*)((const char*)YY + ro_ + q * 512)); } } while (0)
            f32x4 xn_[8]; u32x2 xb_[8]; u32x2 mn_[8]; u32x2 yn_[8];
            if (ja + wave < jb) TP_LOAD(ja + wave);
            for (int j = ja + wave; j < jb; j += NWAVES) {
                asm volatile("" ::: "memory");
                const unsigned ro = (unsigned)((b * RPB + j) * (DM * 2)) + lane * 8u;
                f32x4 xv[8]; u32x2 mw[8]; u32x2 yw[8];
#pragma unroll
                for (int q = 0; q < 8; ++q) { xv[q] = fin ? xn_[q] : (f32x4){bflo(xb_[q].x), bfhi(xb_[q].x), bflo(xb_[q].y), bfhi(xb_[q].y)}; mw[q] = mn_[q]; yw[q] = yn_[q]; }
                if (j + NWAVES < jb) TP_LOAD(j + NWAVES);
                if (MODE != 0) {
                    float ss = 0.f;
#pragma unroll
                    for (int q = 0; q < 8; ++q) { const float m0 = bflo(mw[q].x), m1 = bfhi(mw[q].x), m2 = bflo(mw[q].y), m3 = bfhi(mw[q].y); ss += (m0 * m0 + m1 * m1) + (m2 * m2 + m3 * m3); }
                    const float rs = frsq(wave_sum(ss) * (1.0f / DM) + EPS);
#pragma unroll
                    for (int q = 0; q < 8; ++q) xv[q] = xv[q] + Gs[lane + 64 * q] * (f32x4){bflo(mw[q].x), bfhi(mw[q].x), bflo(mw[q].y), bfhi(mw[q].y)} * rs;
                }
                if (MODE == 2) {
                    float ss = 0.f;
#pragma unroll
                    for (int q = 0; q < 8; ++q) { const float m0 = bflo(yw[q].x), m1 = bfhi(yw[q].x), m2 = bflo(yw[q].y), m3 = bfhi(yw[q].y); ss += (m0 * m0 + m1 * m1) + (m2 * m2 + m3 * m3); }
                    const float rs = frsq(wave_sum(ss) * (1.0f / DM) + EPS);
#pragma unroll
                    for (int q = 0; q < 8; ++q) xv[q] = xv[q] + G2s[lane + 64 * q] * (f32x4){bflo(yw[q].x), bfhi(yw[q].x), bflo(yw[q].y), bfhi(yw[q].y)} * rs;
                    if (out_f32) { const unsigned oo = (unsigned)((b * SEQ + (j - CTXL)) * (DM * 4)) + lane * 16u;
#pragma unroll
                        for (int q = 0; q < 8; ++q) __builtin_nontemporal_store(xv[q], (f32x4*)((char*)a.out + oo + q * 1024)); }
                    else {
#pragma unroll
                        for (int q = 0; q < 8; ++q) { u32x2 w; w.x = pk2(xv[q].x, xv[q].y); w.y = pk2(xv[q].z, xv[q].w); __builtin_nontemporal_store(w, (u32x2*)((char*)XS + ro + q * 512));
                            xv[q] = (f32x4){bflo(w.x), bfhi(w.x), bflo(w.y), bfhi(w.y)}; }
                    }
                }
                if (write_xn) {
                    float ss = 0.f;
#pragma unroll
                    for (int q = 0; q < 8; ++q) ss += (xv[q].x * xv[q].x + xv[q].y * xv[q].y) + (xv[q].z * xv[q].z + xv[q].w * xv[q].w);
                    const float rs = frsq(wave_sum(ss) * (1.0f / DM) + EPS);
#pragma unroll
                    for (int q = 0; q < 8; ++q) { const f32x4 o = xv[q] * rs * As[lane + 64 * q] + Bs[lane + 64 * q];
                        u32x2 w; w.x = pk2(o.x, o.y); w.y = pk2(o.z, o.w); *(u32x2*)((char*)XN + ro + q * 512) = w; }
                }
            }
#undef TP_LOAD
        }
    }
    __syncthreads();
}

DI void t3_hy(const Args& a, int l, LAS unsigned char* lds, int vcu, int G, bool last, int ownx = -1  , int nskip = 0  ) {
    const int tid = opaque_tid(), lane = tid & 63, wave = __builtin_amdgcn_readfirstlane(tid >> 6), gw = vcu * NWAVES + wave, NGW = G * NWAVES;
    const u16* H = (const u16*)(a.ws + WS_H); u16* X0 = (u16*)(a.ws + WS_X0); u16* ZT = (u16*)(a.ws + WS_ZT);
    const float* cw = (const float*)a.in[I_HCW] + (size_t)l * 3 * 1536; const float* cb = (const float*)a.in[I_HCB] + (size_t)l * 1536;
    constexpr int RS = 132;
    LAS unsigned char* tz = lds + wave * (64 * RS);
    const int rr = lane >> 3, ck = lane & 7;
    if (ownx >= 0 && vcu < nskip) return;
    const int it0 = ownx >= 0 ? 576 * ownx + gw - nskip * NWAVES : gw, it1 = ownx >= 0 ? 576 * ownx + 576 : (NROWS / 64) * 8, its = ownx >= 0 ? 256 - nskip * NWAVES : NGW;
    for (int it = it0; it < it1; it += its) {
        const int rt = it >> 3, cgp = it & 7, b = rt / 36, j0 = (rt - b * 36) * 64;
        if (last && j0 < CTXL) continue;
        const int lo = j0 < CTXL ? 0 : CTXL, hiend = j0 < CTXL ? CTXL - 1 : RPB - 1;
        const int c = 64 * cgp + 8 * ck;
        float w[3][3][8], bs[3][8];
#pragma unroll
        for (int set = 0; set < 3; ++set)
#pragma unroll
            for (int e = 0; e < 8; ++e) { const int col = 512 * set + c + e; w[set][0][e] = cw[col]; w[set][1][e] = cw[1536 + col]; w[set][2][e] = cw[3072 + col]; bs[set][e] = cb[col]; }
#pragma unroll 2
        for (int g8 = 0; g8 < 8; ++g8) {
            const int j = j0 + 8 * g8 + rr; const bool hp = j > lo, hn = j < hiend;
            const u16* hr = H + ((size_t)b * RPB + j) * NIN + C_HY + c;
            float u[3][8];
#pragma unroll
            for (int set = 0; set < 3; ++set) {
                const u32x4 wc = *(const u32x4*)(hr + 512 * set);
                u32x4 wp = {0u, 0u, 0u, 0u}, wn = {0u, 0u, 0u, 0u};
                if (hp) wp = *(const u32x4*)(hr - NIN + 512 * set);
                if (hn) wn = *(const u32x4*)(hr + NIN + 512 * set);
#pragma unroll
                for (int e = 0; e < 8; ++e) { const float xp = (e & 1) ? bfhi(wp[e >> 1]) : bflo(wp[e >> 1]), xc = (e & 1) ? bfhi(wc[e >> 1]) : bflo(wc[e >> 1]), xn = (e & 1) ? bfhi(wn[e >> 1]) : bflo(wn[e >> 1]);
                    u[set][e] = w[set][0][e] * xp + w[set][1][e] * xc + w[set][2][e] * xn + bs[set][e]; }
            }
            u32x4 xo; LAS unsigned* pz = (LAS unsigned*)(tz + (8 * g8 + rr) * RS + 16 * ck);
#pragma unroll
            for (int e = 0; e < 4; ++e) { pz[e] = pk2(u[2][2 * e] * u[1][2 * e], u[2][2 * e + 1] * u[1][2 * e + 1]); xo[e] = pk2(u[0][2 * e], u[0][2 * e + 1]); }
            *(u32x4*)(X0 + ((size_t)b * RPB + j) * 512 + c) = xo;
        }
        LDS_WAIT(); asm volatile("" ::: "memory");
        { const int ch4 = lane >> 4, lq = lane & 15;
          const size_t ob = (size_t)b * RPB + j0 + 4 * lq;
#pragma unroll 8
          for (int cc = 0; cc < 64; cc += 4) { const int chl = cc + ch4; const LAS unsigned char* p = tz + (4 * lq) * RS + 2 * chl;
            const unsigned z0 = *(const LAS u16*)(p), z1 = *(const LAS u16*)(p + RS), z2 = *(const LAS u16*)(p + 2 * RS), z3 = *(const LAS u16*)(p + 3 * RS);
            u32x2 zz; zz.x = z0 | (z1 << 16); zz.y = z2 | (z3 << 16);
            *(u32x2*)(ZT + (size_t)(64 * cgp + chl) * NBATCH * RPB + ob) = zz; } }
        LDS_WAIT(); asm volatile("" ::: "memory");
    }
}
DI void t4_hy(const Args& a, int l, LAS unsigned char* lds, int blk, int G, bool last, int ownx = -1  ) {
    const int tid = opaque_tid(), lane = tid & 63, wave = __builtin_amdgcn_readfirstlane(tid >> 6);
    const u16* X0 = (const u16*)(a.ws + WS_X0); const u16* YT = (const u16*)(a.ws + WS_YT); u16* CAT = (u16*)(a.ws + WS_CAT);
    const float* hon = (const float*)a.in[I_HON] + l * 512;
    LAS float* tile = (LAS float*)(lds + wave * (64 * 65 * 4));
    LAS float* part = (LAS float*)(lds + 8 * (64 * 65 * 4));
    const int ch4 = lane >> 4, lq = lane & 15, rr = lane >> 3, ck = lane & 7;
    float hw[8];
#pragma unroll
    for (int e = 0; e < 8; ++e) hw[e] = hon[64 * wave + 8 * ck + e];
    const int rt0 = ownx >= 0 ? 72 * ownx + blk : blk, rt1 = ownx >= 0 ? 72 * ownx + 72 : NROWS / 64, rts = ownx >= 0 ? 32 : G;
    for (int rt = rt0; rt < rt1; rt += rts) {
        const int b = rt / 36, j0 = (rt - b * 36) * 64;
        if (last && j0 < CTXL) continue;
        u32x4 xw[8];
#pragma unroll
        for (int g8 = 0; g8 < 8; ++g8) xw[g8] = __builtin_nontemporal_load((const u32x4*)(X0 + ((size_t)b * RPB + j0 + 8 * g8 + rr) * 512 + 64 * wave + 8 * ck));
        { const size_t ob = (size_t)b * RPB + j0 + 4 * lq;
#pragma unroll 8
          for (int cc = 0; cc < 64; cc += 4) { const int chl = cc + ch4;
            const u32x2 yw = __builtin_nontemporal_load((const u32x2*)(YT + (size_t)(64 * wave + chl) * NBATCH * RPB + ob));
            LAS float* t = tile + (4 * lq) * 65 + chl; t[0] = bflo(yw.x); t[65] = bfhi(yw.x); t[130] = bflo(yw.y); t[195] = bfhi(yw.y); } }
        LDS_WAIT(); asm volatile("" ::: "memory");
        float o[8][8];
#pragma unroll
        for (int g8 = 0; g8 < 8; ++g8) { const int row = 8 * g8 + rr; const LAS float* t = tile + row * 65 + 8 * ck; float ss = 0.f;
#pragma unroll
            for (int e = 0; e < 8; ++e) { const float x0 = (e & 1) ? bfhi(xw[g8][e >> 1]) : bflo(xw[g8][e >> 1]); const float v = x0 * t[e]; o[g8][e] = v; ss += v * v; }
            ss = sum8(ss);
            if (ck == 0) part[wave * 64 + row] = ss; }
        __syncthreads();
#pragma unroll
        for (int g8 = 0; g8 < 8; ++g8) { const int row = 8 * g8 + rr;
            const float tot = sum8(part[ck * 64 + row]);
            const float rs = frsq(tot * (1.0f / 512.0f) + EPS); u32x4 wv;
#pragma unroll
            for (int e = 0; e < 4; ++e) wv[e] = pk2(o[g8][2 * e] * rs * hw[2 * e], o[g8][2 * e + 1] * rs * hw[2 * e + 1]);
            *(u32x4*)(CAT + ((size_t)b * RPB + j0 + row) * DM + 1536 + 64 * wave + 8 * ck) = wv; }
        __syncthreads();
    }
    __syncthreads();
}
DI void mixer_phase(const Args& a, int l, char* ldsg, int vcu, int G, bool last) {
    const int lane = opaque_tid() & 63;
    const u16* H = (const u16*)(a.ws + WS_H); u16* CAT = (u16*)(a.ws + WS_CAT);
#ifndef MIXMASK
#define MIXMASK 7
#endif
    if (MIXMASK & 1) { const float* gon = (const float*)a.in[I_GON] + l * 128;
      const int nun = last ? 1024 : 1152;
      for (int u = vcu; u < nun; u += G) {
        int b, hq, row0, seq;
        if (u < 1024) { b = u >> 6; hq = ((u >> 5) & 1) * 4 + ((u >> 3) & 3); row0 = b * RPB + CTXL + (u & 7) * 256; seq = RPB; }
        else { const int v = u - 1024; b = v >> 3; hq = v & 7; row0 = b * RPB; seq = CTXL; }
        const int kvh = hq >> 2; const size_t kv0 = (size_t)b * RPB * NIN;
        att::attn_unit<0>(H + (size_t)row0 * NIN + C_GQ + hq * 128, H + kv0 + C_GK + kvh * 128, H + kv0 + C_GV + kvh * 128, seq, ldsg, CAT + (size_t)row0 * DM + 512 + hq * 128, gon, 0.f, 1.f);
      } }
    if (MIXMASK & 2) { const float* dl = (const float*)a.in[I_DLAM] + l * 256; const float* subln = (const float*)a.in[I_DSUBLN] + l * 128;
      const float lam_init = 0.8f - 0.6f * expf(-0.3f * (float)l);
      const float lam = expf(wave_sum(dl[lane] * dl[64 + lane])) - expf(wave_sum(dl[128 + lane] * dl[192 + lane])) + lam_init;
      const int nun = last ? 1024 : 1152;
      for (int u = vcu; u < nun; u += G) {
        int b, h, row0, seq;
        if (u < 1024) { b = u >> 6; h = (u >> 4) & 3; row0 = b * RPB + CTXL + (u & 15) * 128; seq = RPB; }
        else { const int v = u - 1024; b = v >> 3; h = (v >> 1) & 3; row0 = b * RPB + (v & 1) * 128; seq = CTXL; }
        const size_t kv0 = (size_t)b * RPB * NIN;
        att::attn_unit<1>(H + (size_t)row0 * NIN + C_DQ + h * 128, H + kv0 + C_DK + h * 128, H + kv0 + C_DV + h * 128, seq, ldsg, CAT + (size_t)row0 * DM + h * 128, subln, lam, 1.0f - lam_init);
      } }
    if (MIXMASK & 4) { const u16* ZT = (const u16*)(a.ws + WS_ZT); u16* YT = (u16*)(a.ws + WS_YT);
      const u16* KFL = (const u16*)(a.ws + WS_KFL) + (size_t)l * 512 * 4096; const u16* KFC = (const u16*)(a.ws + WS_KFC) + (size_t)l * 512 * 512;
      for (int c = vcu; c < 512; c += G) hyena_unit<SEQ>(KFL + (size_t)c * 4096, ZT + (size_t)c * NBATCH * RPB + CTXL, YT + (size_t)c * NBATCH * RPB + CTXL, ldsg);
      if (!last) {
        const int w0 = (G == 256) ? (vcu >= 128 ? vcu - 128 : 512) : vcu, ws = (G == 256) ? 128 : G;
        for (int c = w0; c < 512; c += ws) hyena_unit<CTXL>(KFC + (size_t)c * 512, ZT + (size_t)c * NBATCH * RPB, YT + (size_t)c * NBATCH * RPB, ldsg); }
    }
}

#ifndef REP_P0
#define REP_P0 1
#endif
#ifndef REP_GEMM
#define REP_GEMM 1
#endif
#ifndef REP_MIX
#define REP_MIX 1
#endif
#ifndef REP_THY
#define REP_THY 1
#endif
#ifndef REP_T12
#define REP_T12 0
#endif
#ifndef REP_BAR
#define REP_BAR 1
#endif
#ifndef REP_W
#define REP_W 1
#endif
#define HOSTED false
#ifndef PHMASK
#define PHMASK 0xffff
#endif
#define EN(x) (((PHMASK) >> (x)) & 1)
constexpr int MLP_CH = 32  , NCHUNK = 5, PPL = 16, NPHASE = 2 + NLAYER * PPL;
__global__ void __launch_bounds__(NWAVES * 64, 2) fwd_kernel(Args args) {
    LAS unsigned char* lds = (LAS unsigned char*)lds_raw;
    volatile LAS unsigned* MISC = (volatile LAS unsigned*)(lds + MISC_OFF);
    const int tid = threadIdx.x;
    const int G = gridDim.x, blk = blockIdx.x;
    const int vcu = (G % 8 == 0) ? (blk % 8) * (G / 8) + blk / 8 : blk;
    gu32* ctl = (gu32*)(args.ws + WS_CTL);
    for (int u = tid; u < (LDS_BYTES - LDSCTL_OFF) / 4; u += NWAVES * 64) ((LAS unsigned*)(lds + LDSCTL_OFF))[u] = 0u;
    __syncthreads();
    if ((tid & 63) == 0) ((volatile LAS unsigned*)(lds + WTAB_OFF))[hw_wave_slot()] = (unsigned)(tid >> 6);
    __syncthreads();
    const bool multi = (args.ph_hi - args.ph_lo) > 1;
    XcdBarrier bar; bar.bar = (unsigned*)(ctl + CW_BAR); bar.x = 0; bar.st = nullptr;
    if (multi) bar = xcd_barrier_post((unsigned*)(ctl + CW_BAR), MISC + 8);
#define PH(k) (args.ph_lo <= (k) && (k) < args.ph_hi)
#define SEAM(k) do { if (PH(k) && PH((k) + 1)) for (int rep_ = 0; rep_ < REP_BAR; ++rep_) xcd_barrier(bar); } while (0)
    u16* const XN = (u16*)(args.ws + WS_XN); u16* const HB = (u16*)(args.ws + WS_H); u16* const CAT = (u16*)(args.ws + WS_CAT); u16* const YB = (u16*)(args.ws + WS_YB);

    if (EN(0) && PH(0)) for (int rep = 0; rep < REP_P0; ++rep) {
        __syncthreads();
        for (int rw = 0; rw < REP_W; ++rw) { __syncthreads(); p0_weights(args, lds, vcu, G, 0, HOSTED ? 1 : NLAYER); }
        __syncthreads();
        p0_mod(args, lds, blk, G);
        __syncthreads();
        p0_filters(args, lds, blk, G, 0, HOSTED ? 1 : NLAYER);
        p0_rope(args, blk, G);
    }
    SEAM(0);
    int cb = blk; bool lsync = false;
    if (multi && G == 256) { unsigned okc = 1u;
#pragma unroll
        for (unsigned j = 0; j < 16; ++j) { const unsigned cj = xb_ld((unsigned*)(ctl + CW_BAR) + XB_XCNT(j)); okc &= (j < 8 ? cj == 32u : cj == 0u) ? 1u : 0u; }
        if (__builtin_amdgcn_readfirstlane(okc)) { lsync = true; cb = __builtin_amdgcn_readfirstlane((int)(MISC[10] * 8u + bar.x)); } }
    size_t hid_off = WS_H, yb_off = WS_YB;
    if (lsync) { const size_t x_ = (size_t)(cb & 7), XB_ = (size_t)4608 * NIN * 2;
        hid_off = WS_H + XB_ * x_ - (4 * x_) * ((size_t)256 * DFF * 2);
        yb_off = WS_H + XB_ * x_ + ((size_t)16 << 20) - (4608 * x_) * ((size_t)DM * 2); }
    const int tb = lsync ? (cb & 7) * 32 + (cb >> 3) : blk;
    if (EN(1) && PH(1)) tpass<0>(args, lds, tb, G, 0, 0, 1, 0, true, 3);
    if (lsync) { if (PH(1) && PH(2)) xcd_local_barrier(bar, 32u); } else SEAM(1);
#pragma unroll 1
    for (int l = 0; l < NLAYER; ++l) {
        const int p0 = 2 + l * PPL; const bool last = (l == NLAYER - 1);
        const int npan = last ? 128 : 144;
        if (EN(2) && PH(p0)) {
            pg8::Gemm g{XN, (const u16*)(args.ws + WS_WIN) + (size_t)l * NIN * DM, NROWS, NIN, DM};
            pg8::PanelSched S; S.so.init(NROWS, NIN, G, lsync ? cb : blk); S.base = 0; S.latent_only = false; S.a_local = false; S.o_local = false; S.deal = lsync ? 6 : 0; const bool mid = lsync && !last; if (mid) { S.midbar = bar.bar; S.midx = bar.x; }
            if (last && G == 256) { S.so.init(128 * 256, NIN, G, lsync ? cb : blk); S.latent_only = true; S.deal = 2; S.ctxown = lsync; if (lsync) { S.midbar = bar.bar; S.midx = bar.x; } }
            pg8::EpiQK E{HB, NIN, (const f32x2*)(args.ws + WS_ROPED), (const f32x2*)(args.ws + WS_ROPEG), (const float*)args.in[I_GQN] + l * 128, (const float*)args.in[I_GKN] + l * 128, (LAS float*)(lds + 131072)};
            pg8::gemm_phase<pg8::EpiQK, pg8::PanelSched, true, true>(lds, g, S, E);
            if (HOSTED && !last && blk >= 32) { __syncthreads(); p0_weights(args, lds, blk - 32, 224, l + 1, l + 2); }
        }
        if (lsync) { if (PH(p0) && PH(p0 + 1) && !((cb >> 3) < (last ? 12 : 4))) xcd_local_barrier(bar, 32u); } else SEAM(p0);
        if (EN(3) && PH(p0 + 1)) { for (int rep = 0; rep < REP_THY; ++rep) { if (lsync) t3_hy(args, l, lds, cb >> 3, G, last, cb & 7, last ? 12 : 4); else t3_hy(args, l, lds, vcu, G, last); } }
        SEAM(p0 + 1);
        if (EN(4) && PH(p0 + 2)) for (int rep = 0; rep < REP_MIX; ++rep) mixer_phase(args, l, (char*)lds_raw, vcu, G, last);
        SEAM(p0 + 2);
        if (EN(5) && PH(p0 + 3)) for (int rep = 0; rep < REP_THY; ++rep) { if (lsync) t4_hy(args, l, lds, cb >> 3, G, last, cb & 7); else t4_hy(args, l, lds, blk, G, last); }
        if (lsync) { if (PH(p0 + 3) && PH(p0 + 4)) xcd_local_barrier(bar, 32u); } else SEAM(p0 + 3);
        if (EN(6) && PH(p0 + 4)) {
            pg8::Gemm g{CAT, (const u16*)(args.ws + WS_WOUT) + (size_t)l * DM * DM, npan * 256, DM, DM};
            pg8::PanelSched S; S.so.init(npan * 256, DM, G, lsync ? cb : blk); S.base = 0; S.latent_only = last; S.a_local = false; S.o_local = false; S.deal = (lsync && !last) ? 5 : 0; if (lsync && !last) { S.midbar = bar.bar; S.midx = bar.x; }
            pg8::EpiStore<0> E{(u16*)(args.ws + yb_off), DM};
            for (int rep = 0; rep < REP_GEMM; ++rep) pg8::gemm_phase<pg8::EpiStore<0>, pg8::PanelSched, true, true>(lds, g, S, E);
            if (HOSTED && !last && blk >= 128) { __syncthreads(); p0_filters(args, lds, blk - 128, 128, l + 1, l + 2); }
        }
        const bool g2mid = lsync && !last;
        if (lsync) { if (PH(p0 + 4) && PH(p0 + 5)) { if (!g2mid || (cb >> 3) >= 16) xcd_local_barrier(bar, 32u); else xcd_sub_barrier(bar, 16u); } } else SEAM(p0 + 4);
        if (EN(7) && PH(p0 + 5)) { int xr0 = -1, xl = 144;
            if (g2mid) { const int x_ = cb & 7, rk_ = cb >> 3; if (rk_ >= 16) { xr0 = 4608 * x_ + 256 * (rk_ - 16); xl = 256; } else { xr0 = 4608 * x_ + 4096 + 32 * rk_; xl = 32; } }
            if (l == 0) tpass<1, true>(args, lds, tb, G, l, l, 4, 3, true, 3, 0, 256, false, yb_off, xr0, xl); else tpass<1>(args, lds, tb, G, l, l, 4, 3, true, last ? 2 : 3, 0, 256, false, yb_off, xr0, xl); }
        if (lsync) { if (PH(p0 + 5) && PH(p0 + 6)) xcd_local_barrier(bar, 32u); } else SEAM(p0 + 5);
#pragma unroll 1
        for (int s = 0; s <= 8; ++s) {
            if (PH(p0 + 6 + s)) {
                int dpb = 0, dnp = 0; bool dR = false;
                if (s == 1) { if (!last) { dpb = 128; dnp = 16; dR = true; } } else if (s >= 2 && (s & 1) == 0) { dpb = 32 * ((s - 2) >> 1); dnp = 32; }
                if (EN(9) && dnp > 0) {
                    pg8::Gemm g{(const u16*)(args.ws + (dR ? WS_HIDR : hid_off)), (const u16*)(args.ws + WS_WDN) + (size_t)l * DM * DFF, dnp * 256, DM, DFF};
                    pg8::PanelSched S; S.so.init(dnp * 256, DM, G, cb); S.base = dpb; S.latent_only = last; S.a_local = true; S.o_local = false; S.deal = 0; S.own = lsync; if (lsync && dR) S.so.wgm = 2;
                    pg8::EpiStore<0> E{CAT, DM};
                    pg8::gemm_phase<pg8::EpiStore<0>, pg8::PanelSched, true, true>(lds, g, S, E);
                }
                int upb = 0, unp = 0, deal = 0; bool uR = false;
                if (s == 0) { if (!last) { upb = 128; unp = 16; uR = true; } } else if (s & 1) { upb = 32 * ((s - 1) >> 1); unp = 32; if (s == 1 && !last && G == 256) deal = 1; }
                if (EN(8) && unp > 0) {
                    pg8::Gemm g{XN, (const u16*)(args.ws + WS_WUP) + (size_t)l * DFF * DM, unp * 256, DFF, DM};
                    pg8::PanelSched S; S.so.init(unp * 256, DFF, G, cb); S.base = upb; S.latent_only = last; S.a_local = false; S.o_local = true; S.deal = deal; S.own = lsync; if (lsync && uR) S.so.wgm = 2;
                    pg8::EpiStore<2> E{(u16*)(args.ws + (uR ? WS_HIDR : hid_off)), DFF};
                    pg8::gemm_phase<pg8::EpiStore<2>, pg8::PanelSched, true, true>(lds, g, S, E);
                }
            }
            if (lsync) { if (!(last && s == 0) && PH(p0 + 6 + s) && PH(p0 + 7 + s)) xcd_local_barrier(bar, 32u); }
            else if (!(last && s == 0)) SEAM(p0 + 6 + s);
        }
        if (EN(10) && PH(p0 + 15)) {
            if (l == 0) tpass<2, true>(args, lds, tb, G, l, l + 1, 1, 0, true, 3, 0, 256, false, yb_off); else tpass<2>(args, lds, tb, G, l, last ? l : l + 1, 1, 0, !last, last ? 2 : 3, 0, 256, last, yb_off); }
        if (lsync && !last) { if (PH(p0 + 15) && PH(p0 + 16)) xcd_local_barrier(bar, 32u); } else SEAM(p0 + 15);
    }
#undef PH
#undef SEAM
}

#ifndef MK_PER_PHASE
#define MK_PER_PHASE 0
#endif
extern "C" void kernel_launch(void* const* d_in, const int* in_sizes, int n_in, void* d_out, int out_size, void* d_ws, size_t ws_size, hipStream_t stream) {
    static int grid = 0;
    if (grid == 0) {
        if (n_in != 28 || in_sizes[0] != NBATCH * SEQ * DM || out_size != NBATCH * SEQ * DM || ws_size < WS_END) {
            fprintf(stderr, "kernel_launch: unexpected shapes: n_in %d in0 %d out %d ws %zu (need >= %zu)\n", n_in, n_in > 0 ? in_sizes[0] : -1, out_size, ws_size, (size_t)WS_END); grid = -1; return; }
        int dev = 0, cus = 0, per_cu = 0;
        if (hipGetDevice(&dev) != hipSuccess || hipDeviceGetAttribute(&cus, hipDeviceAttributeMultiprocessorCount, dev) != hipSuccess) { grid = -1; return; }
        if (hipFuncSetAttribute((const void*)fwd_kernel, hipFuncAttributeMaxDynamicSharedMemorySize, LDS_BYTES) != hipSuccess) { fprintf(stderr, "kernel_launch: hipFuncSetAttribute failed\n"); grid = -1; return; }
        if (hipOccupancyMaxActiveBlocksPerMultiprocessor(&per_cu, (const void*)fwd_kernel, NWAVES * 64, LDS_BYTES) != hipSuccess || per_cu < 1)
            fprintf(stderr, "kernel_launch: note: occupancy query reports %d workgroups per CU\n", per_cu);
        (void)hipGetLastError();
        grid = cus;
    }
    if (grid < 0) return;
    if (hipMemsetAsync((char*)d_ws + WS_CTL, 0, CTL_ZERO_BYTES, stream) != hipSuccess) return;
    Args a{};
    for (int i = 0; i < 28; ++i) a.in[i] = d_in[i];
    a.out = (float*)d_out; a.ws = (unsigned char*)d_ws;
#if MK_PER_PHASE
    for (int p = 0; p < NPHASE; ++p) { a.ph_lo = p; a.ph_hi = p + 1; hipLaunchKernelGGL(fwd_kernel, dim3(grid), dim3(NWAVES * 64), LDS_BYTES, stream, a); }
#else
    a.ph_lo = 0; a.ph_hi = NPHASE;
    hipLaunchKernelGGL(fwd_kernel, dim3(grid), dim3(NWAVES * 64), LDS_BYTES, stream, a);
#endif
    const hipError_t le = hipPeekAtLastError();
    if (le != hipSuccess) fprintf(stderr, "kernel_launch: launch failed: %s\n", hipGetErrorName(le));
}
```

```cpp
#include <hip/hip_runtime.h>
#include <cstdio>
#include <cstdint>

#ifndef PG8_WGM
#define PG8_WGM 4
#endif
#define GAS __attribute__((address_space(1)))
#define LAS __attribute__((address_space(3)))
#define DI __device__ __forceinline__
typedef unsigned short u16;
typedef short bf16x8 __attribute__((ext_vector_type(8)));
typedef short s16x4 __attribute__((ext_vector_type(4)));
typedef float f32x2 __attribute__((ext_vector_type(2)));
typedef float f32x4 __attribute__((ext_vector_type(4)));
typedef float f32x16 __attribute__((ext_vector_type(16)));
typedef unsigned u32x2 __attribute__((ext_vector_type(2)));
typedef unsigned u32x4 __attribute__((ext_vector_type(4)));
typedef __bf16 bf16x2_t __attribute__((ext_vector_type(2)));

constexpr int DM = 2048, NBATCH = 16, SEQ = 2048, CTXL = 256, RPB = SEQ + CTXL  , NROWS = NBATCH * RPB  ;
constexpr int NLAYER = 4, NIN = 4608, DFF = 8192, NMOD = 6;
constexpr int C_DQ = 0, C_GQ = 512, C_HY = 1536, C_DK = 3072, C_DV = 3584, C_GK = 4096, C_GV = 4352;
constexpr float EPS = 1e-6f;

DI unsigned pk2(float lo, float hi) { f32x2 v = {lo, hi}; bf16x2_t b = __builtin_convertvector(v, bf16x2_t); return __builtin_bit_cast(unsigned, b); }
DI float bflo(unsigned w) { return __uint_as_float(w << 16); }
DI float bfhi(unsigned w) { return __uint_as_float(w & 0xffff0000u); }
DI float bf1(u16 h) { return __uint_as_float(((unsigned)h) << 16); }
DI u16 tobf(float v) { return (u16)(pk2(v, 0.f) & 0xffffu); }
template <int CTRL> DI float dppf(float v) { return __builtin_bit_cast(float, __builtin_amdgcn_update_dpp(0, __builtin_bit_cast(int, v), CTRL, 0xf, 0xf, true)); }
DI float sum_rows16(float v) {
    auto t = __builtin_amdgcn_permlane16_swap(__float_as_uint(v), __float_as_uint(v), false, false); return __uint_as_float(t[0]) + __uint_as_float(t[1]); }
DI float sum_halves32(float v) {
    auto t = __builtin_amdgcn_permlane32_swap(__float_as_uint(v), __float_as_uint(v), false, false); return __uint_as_float(t[0]) + __uint_as_float(t[1]); }
DI float sum8(float v) { v += dppf<0xB1>(v); v += dppf<0x4E>(v); v += dppf<0x141>(v); return v; }
DI float sum16(float v) { v = sum8(v); v += dppf<0x140>(v); return v; }
DI float sum32(float v) { return sum_rows16(sum16(v)); }
DI float wave_sum(float v) { return sum_halves32(sum32(v)); }
DI float frsq(float x) { return __builtin_amdgcn_rsqf(x); }
DI float rdlane(float v, int l) { return __builtin_bit_cast(float, __builtin_amdgcn_readlane(__builtin_bit_cast(int, v), l)); }

extern __shared__ __attribute__((aligned(16))) unsigned char lds_raw[];
constexpr int WTAB_OFF = 139776;
DI int hw_wave_slot() { return (int)__builtin_amdgcn_s_getreg((5 << 11) | 4) & 63; }
DI int lane_id() { int l; asm volatile("v_mbcnt_lo_u32_b32 %0, -1, 0\n\tv_mbcnt_hi_u32_b32 %0, -1, %0" : "=v"(l)); return l; }
DI int ktid() { const unsigned w = ((volatile LAS unsigned*)((LAS unsigned char*)lds_raw + WTAB_OFF))[hw_wave_slot()]; return (int)__builtin_amdgcn_readfirstlane(w) * 64 + lane_id(); }
DI int opaque_tid() { int t = ktid(); asm volatile("" : "+v"(t)); return t; }

namespace pg8 {
#define PG8_LAS __attribute__((address_space(3)))
typedef unsigned short bf16_t;
typedef short bf16x8 __attribute__((ext_vector_type(8)));
typedef float f32x4 __attribute__((ext_vector_type(4)));
typedef unsigned u32x4 __attribute__((ext_vector_type(4)));
constexpr int BM = 256, BK = 64, HALF = 128, HTB = HALF * BK * 2  , STAGE_BYTES = 8 * HTB, NXCD = 8, WGM = PG8_WGM;

__host__ __device__ __forceinline__ int lds_byte(int r, int c) { const int st = (r >> 4) * 2 + (c >> 5), rr = r & 15, cc = c & 31, ob = rr * 64 + cc * 2; return st * 1024 + (ob ^ (((ob >> 9) & 1) << 5)); }
__host__ __device__ __forceinline__ void stage_rc(int b, int& R, int& C) { const int st = b / 1024, sb = b % 1024, swz = sb ^ (((sb >> 9) & 1) << 5); R = (st >> 1) * 16 + swz / 64; C = (st & 1) * 32 + (swz % 64) / 2; }
__host__ __device__ __forceinline__ int perm32(int rho) { const int n = rho >> 4, i = rho & 15; return 8 * (i >> 2) + 4 * n + (i & 3); }

struct Unit { int pm, pn, pa, fl; };
struct Gemm { const bf16_t* A; const bf16_t* Bt; int M, N, K; };

struct StaticOrder {
    int nM, nN, nwg, G, c, wgm;
    __host__ __device__ void init(int M, int N, int G_, int c_) { nM = M / BM; nN = N / BM; nwg = nM * nN; G = G_; c = c_; wgm = WGM; }
    __host__ __device__ bool next(int i, Unit& u) const {
        const long L = (long)i * G + c; if (L >= nwg) return false;
        int wgid = (int)L; { const int q = nwg / NXCD, r = nwg % NXCD, xcd = wgid % NXCD, off = wgid / NXCD; wgid = (xcd < r ? xcd * (q + 1) : r * (q + 1) + (xcd - r) * q) + off; }
        const int nig = wgm * nN, gid = wgid / nig, fm = gid * wgm, gsz = (nM - fm) < wgm ? (nM - fm) : wgm;
        u.pm = fm + ((wgid % nig) % gsz); u.pn = (wgid % nig) / gsz; return true;
    }
    __device__ __forceinline__ void a_ready(const Unit&) const {}
    __device__ __forceinline__ void done(const Unit&) const {}
};

template <int ACT  > struct EpiStore {
    static constexpr bool PERM = true, AFTER_DRAIN = false;
    bf16_t* O; int ldc;
    __device__ __forceinline__ void operator()(const f32x4 (&acc)[2][2][4][2], const Unit& u, int wr, int wc, int fr, int fq) const {
        const int row0 = u.pm * BM + wr * 64 + fr; const int col0 = u.pn * BM + wc * 32 + 8 * fq;
#pragma unroll
        for (int ai = 0; ai < 2; ++ai)
#pragma unroll
            for (int m = 0; m < 4; ++m) { bf16_t* rowp = O + (size_t)(row0 + ai * HALF + m * 16) * ldc + col0;
#pragma unroll
                for (int bj = 0; bj < 2; ++bj) { f32x4 v0 = acc[ai][bj][m][0], v1 = acc[ai][bj][m][1];
                    if (ACT == 2) {
#pragma unroll
                        for (int e = 0; e < 4; ++e) { float a, b; asm("v_max_f32_e32 %0, 0, %1" : "=v"(a) : "v"(v0[e])); asm("v_max_f32_e32 %0, 0, %1" : "=v"(b) : "v"(v1[e]));
                            v0[e] = a * a; v1[e] = b * b; } }
                    u32x4 w; w.x = pk2(v0[0], v0[1]); w.y = pk2(v0[2], v0[3]); w.z = pk2(v1[0], v1[1]); w.w = pk2(v1[2], v1[3]);
                    *(u32x4*)(rowp + bj * HALF) = w; } }
    }
};
constexpr float QS_DIFF = 0.125f * 1.4426950408889634f;
struct EpiQK {
    static constexpr bool PERM = true, AFTER_DRAIN = false;
    bf16_t* O; int ldc; const f32x2* rd; const f32x2* rg; const float* qn; const float* kn; PG8_LAS float* scr;
    __device__ __forceinline__ void operator()(const f32x4 (&acc)[2][2][4][2], const Unit& u, int wr, int wc, int fr, int fq) const {
        const int pn = u.pn, pj = u.pm % 9; const bool lat = pj != 0; const int tbase = (pj - 1) * 256;
        const int type = (pn < 2 || pn == 12 || pn == 13) ? 1 : ((pn >= 2 && pn < 6) || pn == 16) ? 2 : 0;
        const int row0 = u.pm * BM + wr * 64 + fr; const int col0 = pn * BM + wc * 32 + 8 * fq;
        float rs[2][4][2];
        float wv[8];
#pragma unroll
        for (int e = 0; e < 8; ++e) wv[e] = 1.f;
        if (type == 2) {
            const float* gw = (pn == 16 ? kn : qn) + wc * 32 + 8 * fq;
#pragma unroll
            for (int e = 0; e < 8; ++e) wv[e] = gw[e];
#pragma unroll
            for (int ai = 0; ai < 2; ++ai)
#pragma unroll
                for (int m = 0; m < 4; ++m)
#pragma unroll
                    for (int bj = 0; bj < 2; ++bj) { const f32x4 a = acc[ai][bj][m][0], b = acc[ai][bj][m][1];
                        float s = (a[0] * a[0] + a[1] * a[1]) + (a[2] * a[2] + a[3] * a[3]) + (b[0] * b[0] + b[1] * b[1]) + (b[2] * b[2] + b[3] * b[3]);
                        s = sum_halves32(sum_rows16(s));
                        if (fq == 0) scr[(((wr * 128 + ai * 64 + m * 16 + fr) * 2) + bj) * 4 + wc] = s; }
            asm volatile("s_waitcnt lgkmcnt(0)" ::: "memory"); __builtin_amdgcn_s_barrier(); asm volatile("" ::: "memory");
#pragma unroll
            for (int ai = 0; ai < 2; ++ai)
#pragma unroll
                for (int m = 0; m < 4; ++m)
#pragma unroll
                    for (int bj = 0; bj < 2; ++bj) { const f32x4 p = *(const PG8_LAS f32x4*)(scr + (((wr * 128 + ai * 64 + m * 16 + fr) * 2) + bj) * 4);
                        rs[ai][m][bj] = frsq(((p[0] + p[1]) + (p[2] + p[3])) * (1.0f / 128.0f) + 1e-6f); }
        } else {
#pragma unroll
            for (int ai = 0; ai < 2; ++ai)
#pragma unroll
                for (int m = 0; m < 4; ++m) { rs[ai][m][0] = 1.f; rs[ai][m][1] = 1.f; }
        }
        const bool rope = lat && type != 0;
        if (type == 0) {
#pragma unroll
            for (int ai = 0; ai < 2; ++ai)
#pragma unroll
                for (int m = 0; m < 4; ++m) { bf16_t* rowp = O + (size_t)(row0 + ai * HALF + m * 16) * ldc + col0;
#pragma unroll
                    for (int bj = 0; bj < 2; ++bj) { const f32x4 v0 = acc[ai][bj][m][0], v1 = acc[ai][bj][m][1];
                        u32x4 w; w.x = pk2(v0[0], v0[1]); w.y = pk2(v0[2], v0[3]); w.z = pk2(v1[0], v1[1]); w.w = pk2(v1[2], v1[3]);
                        *(u32x4*)(rowp + bj * HALF) = w; } }
        } else if (type == 1) {
#pragma unroll
            for (int ai = 0; ai < 2; ++ai)
#pragma unroll
                for (int m = 0; m < 4; ++m) { bf16_t* rowp = O + (size_t)(row0 + ai * HALF + m * 16) * ldc + col0;
                    f32x2 cs[4];
#pragma unroll
                    for (int i = 0; i < 4; ++i) cs[i] = (f32x2){1.f, 0.f};
                    if (rope) { const int t = tbase + ai * HALF + wr * 64 + m * 16 + fr; const unsigned co = (unsigned)(t * 32 + 16 * (wc & 1) + 4 * fq) * 8u;
#pragma unroll
                        for (int i = 0; i < 4; ++i) cs[i] = *(const f32x2*)((const char*)rd + co + 8 * i); }
                    const float qs = pn < 2 ? QS_DIFF : 1.0f;
#pragma unroll
                    for (int bj = 0; bj < 2; ++bj) { const f32x4 v0 = acc[ai][bj][m][0], v1 = acc[ai][bj][m][1];
                        const float x[8] = {v0[0] * qs, v0[1] * qs, v0[2] * qs, v0[3] * qs, v1[0] * qs, v1[1] * qs, v1[2] * qs, v1[3] * qs};
                        u32x4 w;
#pragma unroll
                        for (int i = 0; i < 4; ++i) { const float x0 = x[2 * i], x1 = x[2 * i + 1]; w[i] = pk2(x0 * cs[i].x - x1 * cs[i].y, x0 * cs[i].y + x1 * cs[i].x); }
                        *(u32x4*)(rowp + bj * HALF) = w; } }
        } else {
#pragma unroll
            for (int ai = 0; ai < 2; ++ai)
#pragma unroll
                for (int m = 0; m < 4; ++m) { bf16_t* rowp = O + (size_t)(row0 + ai * HALF + m * 16) * ldc + col0;
                    f32x2 cs[4];
#pragma unroll
                    for (int i = 0; i < 4; ++i) cs[i] = (f32x2){1.f, 0.f};
                    if (rope) { const int t = tbase + ai * HALF + wr * 64 + m * 16 + fr; const unsigned co = (unsigned)(t * 64 + 16 * wc + 4 * fq) * 8u;
#pragma unroll
                        for (int i = 0; i < 4; ++i) cs[i] = *(const f32x2*)((const char*)rg + co + 8 * i); }
#pragma unroll
                    for (int bj = 0; bj < 2; ++bj) { const f32x4 v0 = acc[ai][bj][m][0], v1 = acc[ai][bj][m][1]; const float r_ = rs[ai][m][bj];
                        const float x[8] = {v0[0] * r_ * wv[0], v0[1] * r_ * wv[1], v0[2] * r_ * wv[2], v0[3] * r_ * wv[3], v1[0] * r_ * wv[4], v1[1] * r_ * wv[5], v1[2] * r_ * wv[6], v1[3] * r_ * wv[7]};
                        u32x4 w;
#pragma unroll
                        for (int i = 0; i < 4; ++i) { const float x0 = x[2 * i], x1 = x[2 * i + 1]; w[i] = pk2(x0 * cs[i].x - x1 * cs[i].y, x0 * cs[i].y + x1 * cs[i].x); }
                        *(u32x4*)(rowp + bj * HALF) = w; } }
        }
    }
};
}
__device__ void g1_mid_barrier(unsigned* barw, unsigned x);
namespace pg8 {
struct PanelSched {
    StaticOrder so; int base; bool latent_only, a_local, o_local; int deal; unsigned* midbar = nullptr; unsigned midx = 0; bool own = false, ctxown = false;
    __device__ __forceinline__ bool next(int i, Unit& u) const {
        u.fl = 0;
        if (deal == 0) { if (!so.next(i, u)) return false; }
        else if (deal == 5) {
            const int c = so.c, x = c & 7, uu = 32 * i + (c >> 3); if (uu >= 144) return false;
            const int g = uu >> 5, v = uu & 31;
            if (g < 4) { u.pm = 18 * x + 4 * g + (v & 3); u.pn = v >> 2; } else { u.pm = 18 * x + 16 + (v & 1); u.pn = v >> 1; }
            if (midbar != nullptr && i == 3 && (c >> 3) < 16) u.fl = 1;
            u.pa = u.pm; return true; }
        else if (deal == 6) {
            const int c = so.c, x = c & 7, uu = 32 * i + (c >> 3); if (uu >= 324) return false;
            if (uu < 288) { const int g = uu / 72, v = uu - 72 * g; u.pm = 18 * x + 4 * g + (v & 3); u.pn = v >> 2; } else { const int v = uu - 288; u.pm = 18 * x + 16 + (v & 1); u.pn = v >> 1; }
            if (midbar != nullptr && i == 9 && (c >> 3) < 4) u.fl = 1;
            u.pa = u.pm; return true; }
        else if (deal == 2) {
            if (i < 9) { if (!so.next(i, u)) return false; if (midbar != nullptr && i == 8 && (so.c >> 3) < 12) u.fl = 1; }
            else { const int c = so.c; if (i > 9 || c >= 96) return false;
                if (ctxown) { const int rk = c >> 3; u.pm = 9 * (2 * (c & 7) + rk / 6); u.pn = 12 + rk % 6; }
                else { u.pm = 9 * ((c & 7) + 8 * (c / 48)); u.pn = 12 + ((c >> 3) % 6); }
                u.pa = u.pm; return true; } }
        else { const int c = so.c; int L;
            if (c < 128) { if (i >= 2) return false; L = i * 128 + c; } else { if (i >= 6) return false; L = 256 + i * 128 + (c - 128); }
            StaticOrder t = so; t.G = 0; t.c = L; if (!t.next(0, u)) return false; }
        const int lp = base + u.pm; int act;
        if (own) {
            const int c_ = lp >> 5, r_ = lp & 31;
            if (latent_only) { const int ll = 16 * (r_ >> 2) + 4 * c_ + (r_ & 3); act = (ll >> 3) * 9 + 1 + (ll & 7); }
            else if (lp < 128) act = 18 * (r_ >> 2) + 4 * c_ + (r_ & 3);
            else { const int e_ = lp - 128; act = 18 * (e_ >> 1) + 16 + (e_ & 1); } }
        else act = latent_only ? (lp >> 3) * 9 + 1 + (lp & 7) : lp;
        u.pa = a_local ? u.pm : act; u.pm = o_local ? u.pm : act; return true;
    }
    __device__ __forceinline__ void a_ready(const Unit&) const {}
    __device__ __forceinline__ void done(const Unit& u) const { if (u.fl) g1_mid_barrier(midbar, midx); }
};

template <class Epi, class Sched, bool ALIGN_EPI = false, bool SP2 = false>
__device__ __forceinline__ void gemm_phase(PG8_LAS unsigned char* lds, const Gemm g, const Sched& S, const Epi& E) {
    const int tid = opaque_tid(), wid = __builtin_amdgcn_readfirstlane(tid >> 6), lane = tid & 63, wr = wid >> 2, wc = wid & 3, fr = lane & 15, fq = lane >> 4;
    const int K = g.K, nt = K / BK;
    unsigned voffA[2], voffB[2];
#pragma unroll
    for (int i = 0; i < 2; ++i) { int R, C; stage_rc(tid * 16 + i * 8192, R, C); const int Rb = Epi::PERM ? ((R & ~31) + perm32(R & 31)) : R;
        voffA[i] = (unsigned)(R * K + C) * 2u; voffB[i] = (unsigned)(Rb * K + C) * 2u; }
    const size_t kstep = (size_t)(BK * 2);
    const size_t hstep = (size_t)HALF * K * 2;
    const size_t tstep = 2 * hstep;
    const unsigned ldsw = (unsigned)wid * 1024u;
    const int aoff = lds_byte(wr * 64 + fr, fq * 8), boff = lds_byte(wc * 32 + fr, fq * 8);
#define PG8_SA(b, h) (((b) * 2 + (h)) * HTB)
#define PG8_SB(b, h) ((4 + (b) * 2 + (h)) * HTB)
#define PG8_STAGE(bufoff, gbase, voff) do { _Pragma("unroll") for (int _i = 0; _i < 2; ++_i) \
        __builtin_amdgcn_global_load_lds((const unsigned*)((const char*)(gbase) + (voff)[_i]), (PG8_LAS unsigned*)(lds + (bufoff) + ldsw + _i * 8192), 16, 0, 0); } while (0)
#define PG8_LDA(dst, b, h) do { _Pragma("unroll") for (int m = 0; m < 4; ++m) _Pragma("unroll") for (int k = 0; k < 2; ++k) dst[m][k] = *(const PG8_LAS bf16x8*)(lds + PG8_SA(b, h) + aoff + m * 2048 + k * 1024); } while (0)
#define PG8_LDB(dst, b, h) do { _Pragma("unroll") for (int n = 0; n < 2; ++n) _Pragma("unroll") for (int k = 0; k < 2; ++k) dst[n][k] = *(const PG8_LAS bf16x8*)(lds + PG8_SB(b, h) + boff + n * 2048 + k * 1024); } while (0)
#define PG8_MMA(ai, bj, At, Bt) do { __builtin_amdgcn_s_setprio(1); _Pragma("unroll") for (int m = 0; m < 4; ++m) _Pragma("unroll") for (int n = 0; n < 2; ++n) _Pragma("unroll") for (int k = 0; k < 2; ++k) \
        acc[ai][bj][m][n] = __builtin_amdgcn_mfma_f32_16x16x32_bf16(Bt[n][k], At[m][k], acc[ai][bj][m][n], 0, 0, 0); __builtin_amdgcn_s_setprio(0); } while (0)
#define PG8_WAIT_V(n) asm volatile("s_waitcnt vmcnt(" #n ")" ::: "memory")
#define PG8_WAIT_L(n) asm volatile("s_waitcnt lgkmcnt(" #n ")" ::: "memory")
#define PG8_BAR __builtin_amdgcn_s_barrier()
#define PG8_SCHED __builtin_amdgcn_sched_barrier(0)
    Unit cur, nxt; int ui = 0;
    if (!S.next(0, cur)) return;
    f32x4 acc[2][2][4][2];
#pragma unroll
    for (int a = 0; a < 2; ++a)
#pragma unroll
        for (int b = 0; b < 2; ++b)
#pragma unroll
            for (int m = 0; m < 4; ++m)
#pragma unroll
                for (int n = 0; n < 2; ++n) acc[a][b][m][n] = (f32x4){0.f, 0.f, 0.f, 0.f};
    bf16x8 At[4][2], B0[2][2], B1[2][2];
    const char* cA = (const char*)g.A + (size_t)cur.pa * tstep; const char* cB = (const char*)g.Bt + (size_t)cur.pn * tstep;
    S.a_ready(cur);
    if constexpr (SP2) {
        PG8_STAGE(PG8_SB(0, 0), cB, voffB); PG8_STAGE(PG8_SB(0, 1), cB + hstep, voffB); PG8_STAGE(PG8_SA(0, 0), cA, voffA); PG8_STAGE(PG8_SA(0, 1), cA + hstep, voffA);
        if (wr == 1) PG8_BAR;
        PG8_WAIT_V(2); PG8_BAR;
        PG8_STAGE(PG8_SB(1, 0), cB + kstep, voffB); PG8_STAGE(PG8_SA(1, 0), cA + kstep, voffA); PG8_STAGE(PG8_SB(1, 1), cB + hstep + kstep, voffB);
        PG8_WAIT_V(6); PG8_BAR;
    } else {
        PG8_STAGE(PG8_SB(0, 0), cB, voffB); PG8_STAGE(PG8_SA(0, 0), cA, voffA); PG8_STAGE(PG8_SB(0, 1), cB + hstep, voffB); PG8_STAGE(PG8_SA(0, 1), cA + hstep, voffA);
        if (wr == 1) PG8_BAR;
        PG8_WAIT_V(4); PG8_BAR;
        PG8_STAGE(PG8_SB(1, 0), cB + kstep, voffB); PG8_STAGE(PG8_SA(1, 0), cA + kstep, voffA); PG8_STAGE(PG8_SB(1, 1), cB + hstep + kstep, voffB);
        PG8_WAIT_V(6); PG8_BAR;
    }
    for (;;) {
        const bool has_next = S.next(ui + 1, nxt);
        const char* nA = has_next ? (const char*)g.A + (size_t)nxt.pa * tstep : cA; const char* nB = has_next ? (const char*)g.Bt + (size_t)nxt.pn * tstep : cB;
        for (int t = 0; t < nt; t += 2) {
            const bool last = (t == nt - 2);
            const char* a1 = cA + (size_t)(t + 1) * kstep;
            const char* a2 = last ? nA : cA + (size_t)(t + 2) * kstep; const char* b2 = last ? nB : cB + (size_t)(t + 2) * kstep;
            const char* a3 = a2 + kstep; const char* b3 = b2 + kstep;
            if (last && has_next) S.a_ready(nxt);
            if constexpr (SP2) {
            PG8_LDB(B0, 0, 0); PG8_LDB(B1, 0, 1); PG8_SCHED; PG8_LDA(At, 0, 0); PG8_STAGE(PG8_SA(1, 1), a1 + hstep, voffA);
            PG8_WAIT_V(8); PG8_WAIT_L(0); PG8_BAR; PG8_MMA(0, 0, At, B0); PG8_MMA(0, 1, At, B1); PG8_BAR; PG8_SCHED;
            PG8_LDA(At, 0, 1); PG8_STAGE(PG8_SB(0, 0), b2, voffB); PG8_STAGE(PG8_SB(0, 1), b2 + hstep, voffB); PG8_STAGE(PG8_SA(0, 0), a2, voffA);
            PG8_WAIT_V(8); PG8_WAIT_L(0); PG8_BAR; PG8_MMA(1, 0, At, B0); PG8_MMA(1, 1, At, B1); PG8_BAR; PG8_SCHED;
            PG8_LDB(B0, 1, 0); PG8_LDB(B1, 1, 1); PG8_SCHED; PG8_LDA(At, 1, 0); PG8_STAGE(PG8_SA(0, 1), a2 + hstep, voffA);
            PG8_WAIT_V(8); PG8_WAIT_L(0); PG8_BAR; PG8_MMA(0, 0, At, B0); PG8_MMA(0, 1, At, B1); PG8_BAR; PG8_SCHED;
            PG8_LDA(At, 1, 1); PG8_STAGE(PG8_SB(1, 0), b3, voffB); PG8_STAGE(PG8_SB(1, 1), b3 + hstep, voffB); PG8_STAGE(PG8_SA(1, 0), a3, voffA);
            PG8_WAIT_V(8); PG8_WAIT_L(0); PG8_BAR; PG8_MMA(1, 0, At, B0); PG8_MMA(1, 1, At, B1); PG8_BAR; PG8_SCHED;
            } else {
            PG8_LDB(B0, 0, 0); PG8_SCHED; PG8_LDA(At, 0, 0); PG8_STAGE(PG8_SA(1, 1), a1 + hstep, voffA);
            PG8_WAIT_L(8); PG8_BAR; PG8_WAIT_L(0); PG8_MMA(0, 0, At, B0); PG8_BAR; PG8_SCHED;
            PG8_LDB(B1, 0, 1); PG8_STAGE(PG8_SB(0, 0), b2, voffB);
            PG8_BAR; PG8_WAIT_L(0); PG8_MMA(0, 1, At, B1); PG8_BAR;
            PG8_LDA(At, 0, 1); PG8_STAGE(PG8_SA(0, 0), a2, voffA);
            PG8_BAR; PG8_WAIT_L(0); PG8_MMA(1, 0, At, B0); PG8_BAR; PG8_SCHED;
            PG8_STAGE(PG8_SB(0, 1), b2 + hstep, voffB);
            PG8_WAIT_V(6); PG8_BAR; PG8_MMA(1, 1, At, B1); PG8_BAR;
            PG8_LDB(B0, 1, 0); PG8_SCHED; PG8_LDA(At, 1, 0); PG8_STAGE(PG8_SA(0, 1), a2 + hstep, voffA);
            PG8_WAIT_L(8); PG8_BAR; PG8_WAIT_L(0); PG8_MMA(0, 0, At, B0); PG8_BAR; PG8_SCHED;
            PG8_LDB(B1, 1, 1); PG8_STAGE(PG8_SB(1, 0), b3, voffB);
            PG8_BAR; PG8_WAIT_L(0); PG8_MMA(0, 1, At, B1); PG8_BAR;
            PG8_LDA(At, 1, 1); PG8_STAGE(PG8_SA(1, 0), a3, voffA);
            PG8_BAR; PG8_WAIT_L(0); PG8_MMA(1, 0, At, B0); PG8_BAR; PG8_SCHED;
            PG8_STAGE(PG8_SB(1, 1), b3 + hstep, voffB);
            PG8_WAIT_V(6); PG8_BAR; PG8_MMA(1, 1, At, B1); PG8_BAR;
            }
        }
        if constexpr (ALIGN_EPI) { if (wr == 0) PG8_BAR; }
        if constexpr (!Epi::AFTER_DRAIN) { E(acc, cur, wr, wc, fr, fq); S.done(cur); }
        if (!has_next) break;
#pragma unroll
        for (int a = 0; a < 2; ++a)
#pragma unroll
            for (int b = 0; b < 2; ++b)
#pragma unroll
                for (int m = 0; m < 4; ++m)
#pragma unroll
                    for (int n = 0; n < 2; ++n) acc[a][b][m][n] = (f32x4){0.f, 0.f, 0.f, 0.f};
        cur = nxt; cA = nA; cB = nB; ++ui;
        if constexpr (ALIGN_EPI) { if (wr == 1) PG8_BAR; }
    }
    PG8_WAIT_V(0);
    if constexpr (!ALIGN_EPI) { if (wr == 0) PG8_BAR; }
    PG8_BAR;
    if constexpr (Epi::AFTER_DRAIN) { E.fused(acc, cur, wr, wc, fr, fq, lds, wid, lane); S.done(cur); }
#undef PG8_SA
#undef PG8_SB
#undef PG8_STAGE
#undef PG8_LDA
#undef PG8_LDB
#undef PG8_MMA
#undef PG8_WAIT_V
#undef PG8_WAIT_L
#undef PG8_BAR
#undef PG8_SCHED
}
}
namespace att {
constexpr int NW = 8, QBLK = 32, KVBLK = 64, LDH = NIN;
constexpr float THR = 16.f;
constexpr size_t SHM_V = KVBLK * 128 * 2, SHM_K = KVBLK * 128 * 2, SHM_ATTN = 2 * SHM_V + 2 * SHM_K + NW * 64 * 4;
#define KSWZ(row, colB) ((row) * 256 + ((colB) ^ (((row) & 7) << 4)))
#define SBAR() __builtin_amdgcn_sched_barrier(0)
DI int crow(int r, int hi) { return (r & 3) + 8 * (r >> 2) + 4 * hi; }
DI unsigned cvtpk(float lo, float hi) { unsigned r; asm volatile("v_cvt_pk_bf16_f32 %0, %1, %2" : "=v"(r) : "v"(lo), "v"(hi)); return r; }

DI float max3a(float a, float b, float c) { float d; asm("v_max3_f32 %0, %1, %2, %3" : "=v"(d) : "v"(a), "v"(b), "v"(c)); return d; }
DI float max2a(float a, float b) { float d; asm("v_max_f32_e32 %0, %1, %2" : "=v"(d) : "v"(a), "v"(b)); return d; }
DI float maxchain(float m, const f32x16& p) {
  asm("v_max3_f32 %0, %0, %1, %2\n\tv_max3_f32 %0, %0, %3, %4\n\tv_max3_f32 %0, %0, %5, %6\n\tv_max3_f32 %0, %0, %7, %8\n\tv_max3_f32 %0, %0, %9, %10\n\tv_max3_f32 %0, %0, %11, %12\n\tv_max3_f32 %0, %0, %13, %14"
      : "+v"(m) : "v"(p[2]), "v"(p[3]), "v"(p[4]), "v"(p[5]), "v"(p[6]), "v"(p[7]), "v"(p[8]), "v"(p[9]), "v"(p[10]), "v"(p[11]), "v"(p[12]), "v"(p[13]), "v"(p[14]), "v"(p[15]));
  return m; }
template <int KB> DI float fmamk(float p, float m) { float d; asm("v_fmamk_f32 %0, %1, %3, %2" : "=v"(d) : "v"(p), "v"(m), "n"(KB)); return d; }
template <int CB>
DI void partialSM(f32x16& p0, f32x16& p1, float& m_reg, float& mn, float& alpha, const float C, const float THRS, const float INF  ) {
  float ma = __builtin_amdgcn_fmed3f(p0[0], p0[1], INF), mb = __builtin_amdgcn_fmed3f(p1[0], p1[1], INF);
  ma = maxchain(ma, p0); mb = maxchain(mb, p1);
  float pmax = max2a(ma, mb);
  { auto rr = __builtin_amdgcn_permlane32_swap(__float_as_uint(pmax), __float_as_uint(pmax), false, false);
    pmax = max2a(__uint_as_float(rr[0]), __uint_as_float(rr[1])); }
  if (__builtin_expect(__all(pmax - m_reg <= THRS), 1)) { mn = m_reg; alpha = 1.f; }
  else { asm volatile("; new row max");
    mn = max2a(m_reg, pmax); alpha = __builtin_amdgcn_exp2f((m_reg - mn) * C); m_reg = mn; }
  const float mnC = -mn * C;
#pragma unroll
  for (int r = 0; r < 16; ++r) p0[r] = fmamk<CB>(p0[r], mnC);
#pragma unroll
  for (int r = 0; r < 16; ++r) p1[r] = fmamk<CB>(p1[r], mnC);
#pragma unroll
  for (int r = 0; r < 16; ++r) p0[r] = __builtin_amdgcn_exp2f(p0[r]);
}
template <bool FIRST>
DI void partialSM2(f32x16& p0, f32x16& p1, f32x16& negm, float& alpha, const float THR2, const float INF) {
  float ma = __builtin_amdgcn_fmed3f(p0[0], p0[1], INF), mb = __builtin_amdgcn_fmed3f(p1[0], p1[1], INF);
  ma = maxchain(ma, p0); mb = maxchain(mb, p1);
  float pmax = max2a(ma, mb);
  { auto rr = __builtin_amdgcn_permlane32_swap(__float_as_uint(pmax), __float_as_uint(pmax), false, false);
    pmax = max2a(__uint_as_float(rr[0]), __uint_as_float(rr[1])); }
  if (!FIRST && __builtin_expect(__all(pmax <= THR2), 1)) { alpha = 1.f; }
  else { if (!FIRST) asm volatile("; new row max");
    const float delta = FIRST ? pmax : max2a(pmax, 0.f);
    alpha = FIRST ? 1.f : __builtin_amdgcn_exp2f(-delta);
    const float nm = negm[0] - delta;
#pragma unroll
    for (int r = 0; r < 16; ++r) { p0[r] -= delta; p1[r] -= delta; negm[r] = nm; } }
#pragma unroll
  for (int r = 0; r < 16; ++r) p0[r] = __builtin_amdgcn_exp2f(p0[r]);
}
DI void finishSM(f32x16& p0, f32x16& p1, float alpha, float& l_reg, bf16x8& pa0, bf16x8& pa1, bf16x8& pa2, bf16x8& pa3) {
#pragma unroll
  for (int r = 0; r < 16; ++r) p1[r] = __builtin_amdgcn_exp2f(p1[r]);
  float ps = 0;
#pragma unroll
  for (int r = 0; r < 16; ++r) ps += p0[r];
#pragma unroll
  for (int r = 0; r < 16; ++r) ps += p1[r];
  { auto rr = __builtin_amdgcn_permlane32_swap(__float_as_uint(ps), __float_as_uint(ps), false, false);
    ps = __uint_as_float(rr[0]) + __uint_as_float(rr[1]); }
  l_reg = l_reg * alpha + ps;
#define PK4(P, BASE, OUT) do { unsigned a0 = cvtpk(P[BASE + 0], P[BASE + 1]), a1 = cvtpk(P[BASE + 2], P[BASE + 3]);   \
    unsigned b0 = cvtpk(P[BASE + 4], P[BASE + 5]), b1 = cvtpk(P[BASE + 6], P[BASE + 7]);                              \
    auto r0 = __builtin_amdgcn_permlane32_swap(a0, b0, false, false); auto r1 = __builtin_amdgcn_permlane32_swap(a1, b1, false, false); \
    u32x4 w = {r0[0], r1[0], r0[1], r1[1]}; OUT = *reinterpret_cast<bf16x8*>(&w); } while (0)
  PK4(p0, 0, pa0); PK4(p0, 8, pa1); PK4(p1, 0, pa2); PK4(p1, 8, pa3);
#undef PK4
}
template <int ND0> DI void qkt(f32x16& p0, f32x16& p1, const char* Ks, const bf16x8* qr, int r32, int hi, int cb0, const f32x16& init) {
  p0 = init; p1 = init;
#pragma unroll
  for (int d0 = 0; d0 < ND0; ++d0) { const int cb = cb0 + (d0 * 16 + hi * 8) * 2;
    const bf16x8 b0 = *reinterpret_cast<const bf16x8*>(Ks + KSWZ(r32, cb));
    const bf16x8 b1 = *reinterpret_cast<const bf16x8*>(Ks + KSWZ(32 + r32, cb));
    p0 = __builtin_amdgcn_mfma_f32_32x32x16_bf16(b0, qr[d0], p0, 0, 0, 0);
    p1 = __builtin_amdgcn_mfma_f32_32x32x16_bf16(b1, qr[d0], p1, 0, 0, 0); }
}
DI int v_st(int k, int c) { const int kk = (k & ~0xC) | ((k & 4) << 1) | ((k & 8) >> 1); return ((kk >> 3) * 4 + (c >> 5)) * 512 + ((kk & 7) * 32 + (c & 31)) * 2; }
DI int v_rd_base(int lane) { return ((lane & 3) << 3) | (((lane >> 2) & 3) << 6) | (((lane >> 4) & 1) << 5) | (((lane >> 5) & 1) << 8); }
constexpr int v_rd_off(int d0, int ks, int half) { return d0 * 512 + ks * 4096 + half * 2048; }
template <int OFF> DI s16x4 tr_read(int vb) {
  s16x4 r; asm volatile("ds_read_b64_tr_b16 %0, %1 offset:%2" : "=&v"(r) : "v"(vb), "i"(OFF) : "memory"); return r;
}
template <int D0> DI void pv_one(f32x16& od, int vb, bf16x8 pa0, bf16x8 pa1, bf16x8 pa2, bf16x8 pa3) {
  const s16x4 l0 = tr_read<v_rd_off(D0, 0, 0)>(vb), h0 = tr_read<v_rd_off(D0, 0, 1)>(vb), l1 = tr_read<v_rd_off(D0, 1, 0)>(vb), h1 = tr_read<v_rd_off(D0, 1, 1)>(vb);
  const s16x4 l2 = tr_read<v_rd_off(D0, 2, 0)>(vb), h2 = tr_read<v_rd_off(D0, 2, 1)>(vb), l3 = tr_read<v_rd_off(D0, 3, 0)>(vb), h3 = tr_read<v_rd_off(D0, 3, 1)>(vb);
  asm volatile("s_waitcnt lgkmcnt(0)" ::: "memory"); SBAR();
#define PK(L, H) (bf16x8){L[0], L[1], L[2], L[3], H[0], H[1], H[2], H[3]}
  od = __builtin_amdgcn_mfma_f32_32x32x16_bf16(pa0, PK(l0, h0), od, 0, 0, 0);
  od = __builtin_amdgcn_mfma_f32_32x32x16_bf16(pa1, PK(l1, h1), od, 0, 0, 0);
  od = __builtin_amdgcn_mfma_f32_32x32x16_bf16(pa2, PK(l2, h2), od, 0, 0, 0);
  od = __builtin_amdgcn_mfma_f32_32x32x16_bf16(pa3, PK(l3, h3), od, 0, 0, 0);
#undef PK
}
DI void pv_d0(f32x16* o, int vb, bf16x8 pa0, bf16x8 pa1, bf16x8 pa2, bf16x8 pa3) {
  pv_one<0>(o[0], vb, pa0, pa1, pa2, pa3); pv_one<1>(o[1], vb, pa0, pa1, pa2, pa3); pv_one<2>(o[2], vb, pa0, pa1, pa2, pa3); pv_one<3>(o[3], vb, pa0, pa1, pa2, pa3);
}

template <int MODE>
DI void attn_unit(const u16* __restrict__ Qb, const u16* __restrict__ Kh, const u16* __restrict__ Vh, int seq, char* lds,
                  u16* __restrict__ Ob, const float* __restrict__ gvec, float lam, float post) {
  constexpr int ND0 = MODE ? 4 : 8;
  constexpr float SCALE = MODE ? 0.125f : 0.088388347648318440f;
  constexpr float C = SCALE * 1.4426950408889634f, THRS = THR / SCALE; constexpr int CB = __builtin_bit_cast(int, C); constexpr float THR2 = THR * 1.4426950408889634f;
  int tid_ = ktid(); asm volatile("" : "+v"(tid_));
  const int tid = tid_, wid = __builtin_amdgcn_readfirstlane(tid >> 6), lane = tid & 63, r32 = lane & 31, hi = lane >> 5;
  int infb_ = 0x7f800000; asm("" : "+s"(infb_)); const float INF = __int_as_float(infb_);
  const int wq = MODE ? (wid & 3) : wid, mp = MODE ? (wid >> 2) : 0;
  char* V_lds = lds; char* K_lds = lds + 2 * SHM_V;
  float* ws = (float*)(lds + 2 * SHM_V + 2 * SHM_K) + wid * 64; float* li_l = ws; float* al_l = ws + 32;
  float m_reg = -1e30f, l_reg = 0; f32x16 o[4] = {}; f32x16 negm = {}; bf16x8 qr[ND0];
  const u16* Qw = Qb + (long)(wq * QBLK + r32) * LDH + mp * 64 + hi * 8;
#pragma unroll
  for (int d0 = 0; d0 < ND0; ++d0) qr[d0] = *reinterpret_cast<const bf16x8*>(Qw + d0 * 16);
  const int cb0 = mp * 128;
  const int sr = tid >> 4, sc = (tid & 15) * 8, vst0 = v_st(sr, sc), vst1 = v_st(32 + sr, sc);
  const int vb0 = (int)(uintptr_t)V_lds + v_rd_base(lane);
  struct { bf16x8 vs0, vs1, ks0, ks1; } sr_[2];
#define SLOAD(i, k0) do { sr_[i].vs0 = *reinterpret_cast<const bf16x8*>(&Vh[(long)((k0) + sr) * LDH + sc]); sr_[i].vs1 = *reinterpret_cast<const bf16x8*>(&Vh[(long)((k0) + 32 + sr) * LDH + sc]); \
    sr_[i].ks0 = *reinterpret_cast<const bf16x8*>(&Kh[(long)((k0) + sr) * LDH + sc]); sr_[i].ks1 = *reinterpret_cast<const bf16x8*>(&Kh[(long)((k0) + 32 + sr) * LDH + sc]); } while (0)
#define SWRITE(b, i) do { *(bf16x8*)(V_lds + (b) * SHM_V + vst0) = sr_[i].vs0;          \
    *(bf16x8*)(V_lds + (b) * SHM_V + vst1) = sr_[i].vs1; const int kc = sc * 2;               \
    *(bf16x8*)(K_lds + (b) * SHM_K + KSWZ(sr, kc)) = sr_[i].ks0;                       \
    *(bf16x8*)(K_lds + (b) * SHM_K + KSWZ(32 + sr, kc)) = sr_[i].ks1; } while (0)
#define SWAIT() asm volatile("s_waitcnt vmcnt(4)" ::: "memory")
#define RESC(a) do { if (__any((a) < 1.f)) { if (hi == 0) al_l[r32] = (a); asm volatile("s_waitcnt lgkmcnt(0)" ::: "memory"); \
    _Pragma("unroll") for (int d = 0; d < 4; ++d) _Pragma("unroll") for (int r = 0; r < 16; ++r) o[d][r] *= al_l[crow(r, hi)]; } } while (0)
#define PSM(FIRST, p0, p1, mn, al) do { if constexpr (MODE != 0) partialSM2<FIRST>(p0, p1, negm, al, THR2, INF); else partialSM<CB>(p0, p1, m_reg, mn, al, C, THRS, INF); } while (0)
  f32x16 pA0, pA1, pB0, pB1; float mnA, mnB, alA, alB; bf16x8 pa0, pa1, pa2, pa3; const int NT = seq / KVBLK;
  constexpr int SE = 0, SO = 1;
  SLOAD(SE, 0); asm volatile("s_waitcnt vmcnt(0)" ::: "memory"); SWRITE(0, SE); __syncthreads();
  qkt<ND0>(pA0, pA1, K_lds, qr, r32, hi, cb0, negm); PSM(true, pA0, pA1, mnA, alA);
  SLOAD(SO, KVBLK); if (2 < NT) SLOAD(SE, 2 * KVBLK);
  SWAIT(); SWRITE(1, SO); __syncthreads();
  for (int j = 1; j + 1 < NT; j += 2) {
    SBAR(); qkt<ND0>(pB0, pB1, K_lds + SHM_K, qr, r32, hi, cb0, negm);
    finishSM(pA0, pA1, alA, l_reg, pa0, pa1, pa2, pa3); SBAR();
    SLOAD(SO, (j + 2) * KVBLK); SBAR();
    pv_d0(o, vb0, pa0, pa1, pa2, pa3); PSM(false, pB0, pB1, mnB, alB);
    __syncthreads(); SWAIT(); SWRITE(0, SE);
    RESC(alB); __syncthreads();
    SBAR(); qkt<ND0>(pA0, pA1, K_lds, qr, r32, hi, cb0, negm);
    finishSM(pB0, pB1, alB, l_reg, pa0, pa1, pa2, pa3); SBAR();
    if (j + 3 < NT) SLOAD(SE, (j + 3) * KVBLK); SBAR();
    pv_d0(o, vb0 + (int)SHM_V, pa0, pa1, pa2, pa3); PSM(false, pA0, pA1, mnA, alA);
    __syncthreads(); SWAIT(); SWRITE(1, SO);
    RESC(alA); __syncthreads();
  }
  SBAR(); qkt<ND0>(pB0, pB1, K_lds + SHM_K, qr, r32, hi, cb0, negm);
  finishSM(pA0, pA1, alA, l_reg, pa0, pa1, pa2, pa3); SBAR();
  pv_d0(o, vb0, pa0, pa1, pa2, pa3); PSM(false, pB0, pB1, mnB, alB);
  __syncthreads(); RESC(alB);
  finishSM(pB0, pB1, alB, l_reg, pa0, pa1, pa2, pa3); SBAR();
  pv_d0(o, vb0 + (int)SHM_V, pa0, pa1, pa2, pa3);
  if (hi == 0) li_l[r32] = l_reg; asm volatile("s_waitcnt lgkmcnt(0)" ::: "memory");
  float rli[16];
#pragma unroll
  for (int r = 0; r < 16; ++r) rli[r] = __builtin_amdgcn_rcpf(li_l[crow(r, hi)]);
#pragma unroll
  for (int d0 = 0; d0 < 4; ++d0)
#pragma unroll
    for (int r = 0; r < 16; ++r) o[d0][r] *= rli[r];
  if (MODE) {
    __syncthreads();
    float* ex = (float*)lds + (wq * 64) * 64 + lane;
    if (mp == 1) {
#pragma unroll
      for (int d0 = 0; d0 < 4; ++d0)
#pragma unroll
        for (int r = 0; r < 16; ++r) ex[(d0 * 16 + r) * 64] = o[d0][r];
    }
    __syncthreads();
    if (mp == 0) {
#pragma unroll
      for (int d0 = 0; d0 < 4; ++d0)
#pragma unroll
        for (int r = 0; r < 16; ++r) o[d0][r] -= lam * ex[(d0 * 16 + r) * 64];
    }
  }
  if (mp == 0) {
    float gw[4];
#pragma unroll
    for (int d0 = 0; d0 < 4; ++d0) gw[d0] = gvec[d0 * 32 + r32] * post;
    u16* Ow = Ob + (long)(wq * QBLK) * DM;
#pragma unroll
    for (int r = 0; r < 16; ++r) {
      float s = 0.f;
#pragma unroll
      for (int d0 = 0; d0 < 4; ++d0) s += o[d0][r] * o[d0][r];
      s = sum32(s);
      const float rs = frsq(s * (1.0f / 128.0f) + EPS);
      const int orow = crow(r, hi);
#pragma unroll
      for (int d0 = 0; d0 < 4; ++d0) Ow[(long)orow * DM + d0 * 32 + r32] = tobf(o[d0][r] * rs * gw[d0]);
    }
  }
  __syncthreads();
#undef SLOAD
#undef SWRITE
#undef SWAIT
#undef RESC
#undef PSM
}
#undef SBAR
}

template <int N>
DI void hyena_unit(const u16* __restrict__ KFc, const u16* __restrict__ ZTc, u16* __restrict__ YTc, char* ldsg) {
  constexpr int CL = 2 * N + 8, CS = CL * 2 + 16;
  constexpr int BS = N * 2 + 16;
  constexpr int BOFF = 8 * CS;
  constexpr int NMT = N / 128;
  LAS char* lds = (LAS char*)ldsg;
  int tid_ = ktid(); asm volatile("" : "+v"(tid_));
  const int tid = tid_, wid = __builtin_amdgcn_readfirstlane(tid >> 6), lane = tid & 63;
  for (int e = tid; e < 2 * N / 8; e += 512) { const bf16x8 v = *reinterpret_cast<const bf16x8*>(KFc + 8 * e);
#pragma unroll
    for (int jj = 0; jj < 8; ++jj) { const int y = 2 * N - (8 * e + jj);
#pragma unroll
      for (int r = 0; r < 8; ++r) *(LAS u16*)(lds + r * CS + 2 * (y + r)) = (u16)v[jj]; } }
  for (int e = tid; e < 16 * (N / 8); e += 512) { const int b = e / (N / 8), ch = e - b * (N / 8);
    *(LAS bf16x8*)(lds + BOFF + b * BS + 16 * ch) = *reinterpret_cast<const bf16x8*>(ZTc + (long)b * RPB + 8 * ch); }
  __syncthreads();
  const int i = lane & 15, q = lane >> 4, r = i & 7;
  const int abase = r * CS + 2 * (N - (i - r) + 8 * q) - 32 * (wid * NMT);
  const int bbase = BOFF + i * BS + 16 * q;
  f32x4 acc[NMT];
#pragma unroll
  for (int mi = 0; mi < NMT; ++mi) acc[mi] = (f32x4){0.f, 0.f, 0.f, 0.f};
  bf16x8 F[NMT];
#pragma unroll
  for (int mi = 2; mi < NMT; ++mi) F[(NMT - mi) % NMT] = *(const LAS bf16x8*)(lds + abase - 32 * mi);
  constexpr int UNR = NMT / 2;
  for (int kt0 = 0; kt0 < N / 32; kt0 += UNR) {
#pragma unroll
    for (int kk = 0; kk < UNR; ++kk) { const int kt = kt0 + kk;
      F[(2 * kk + NMT - 1) % NMT] = *(const LAS bf16x8*)(lds + abase + 32 * (2 * kt - 1));
      F[(2 * kk) % NMT] = *(const LAS bf16x8*)(lds + abase + 32 * (2 * kt));
      const bf16x8 bf = *(const LAS bf16x8*)(lds + bbase + 64 * kt);
#pragma unroll
      for (int mi = NMT - 1; mi >= 0; --mi) acc[mi] = __builtin_amdgcn_mfma_f32_16x16x32_bf16(F[(2 * kk - mi + 2 * NMT) % NMT], bf, acc[mi], 0, 0, 0);
    }
  }
#pragma unroll
  for (int mi = 0; mi < NMT; ++mi) { const int t0 = 16 * (wid * NMT + mi) + 4 * q;
    u32x2 w; w.x = pk2(acc[mi][0], acc[mi][1]); w.y = pk2(acc[mi][2], acc[mi][3]);
    *reinterpret_cast<u32x2*>(YTc + (long)i * RPB + t0) = w; }
  __syncthreads();
}

constexpr int NWAVES = 8;
constexpr size_t MiB = 1u << 20;
constexpr size_t WS_CTL = 0, CTL_ZERO_BYTES = 64 * 1024;
constexpr size_t WS_WIN = 1 * MiB;
constexpr size_t WS_WOUT = WS_WIN + 72 * MiB;
constexpr size_t WS_WUP = WS_WOUT + 32 * MiB;
constexpr size_t WS_WDN = WS_WUP + 128 * MiB;
constexpr size_t WS_MODV = WS_WDN + 128 * MiB;
constexpr size_t WS_ROPED = WS_MODV + 4 * MiB;
constexpr size_t WS_ROPEG = WS_ROPED + 1 * MiB;
constexpr size_t WS_KFL = WS_ROPEG + 1 * MiB;
constexpr size_t WS_KFC = WS_KFL + 16 * MiB;
constexpr size_t WS_XS = WS_KFC + 2 * MiB;
constexpr size_t WS_XN = WS_XS + 144 * MiB;
constexpr size_t WS_H = WS_XN + 144 * MiB;
constexpr size_t WS_YB = WS_H + 128 * MiB;
constexpr size_t WS_CAT = WS_H + 324 * MiB;
constexpr size_t WS_X0 = WS_CAT + 144 * MiB;
constexpr size_t WS_ZT = WS_X0 + 36 * MiB;
constexpr size_t WS_YT = WS_ZT + 36 * MiB;
constexpr size_t WS_HIDR = WS_YT + 36 * MiB;
constexpr size_t WS_END = WS_HIDR + 64 * MiB;
constexpr int CW_BAR = 4096;

constexpr int SCR_BYTES = 139264;
constexpr int LDSCTL_OFF = SCR_BYTES, MISC_OFF = LDSCTL_OFF + 320;
constexpr int LDS_BYTES = 147456;
static_assert(MISC_OFF + 128 <= WTAB_OFF && WTAB_OFF + 256 <= LDS_BYTES, "LDS map");

typedef GAS unsigned gu32;
#define RLX_AGENT __ATOMIC_RELAXED, __HIP_MEMORY_SCOPE_AGENT
#define LDS_WAIT() asm volatile("s_waitcnt lgkmcnt(0)" ::: "memory")

#define XB_TMO      128
#define XB_XCNT(j)  (256  + 64 * (j))
#define XB_XSUB(j)  (1280 + 64 * (j))
#define XB_XGEN(j)  (2304 + 64 * (j))
#define XB_TOP      3328
#define XB_TOPGEN   3392
#define XCD_BAR_WORDS 3456
#define XB_SPIN_CAP (1u << 18)

__device__ __forceinline__ unsigned xb_ld(unsigned* p)              { return __hip_atomic_load(p, __ATOMIC_RELAXED, __HIP_MEMORY_SCOPE_AGENT); }
__device__ __forceinline__ unsigned xb_add(unsigned* p, unsigned v) { return __hip_atomic_fetch_add(p, v, __ATOMIC_RELAXED, __HIP_MEMORY_SCOPE_AGENT); }
__device__ __forceinline__ unsigned xb_xcc_id() { return (unsigned)__builtin_amdgcn_s_getreg((3 << 11) | 20) & 0xFu; }
#define XB_SPIN(cond, bar) do { unsigned _sp = 0; while (cond) { __builtin_amdgcn_s_sleep(1); \
    if ((++_sp & 255u) == 0u) { if (xb_ld(&(bar)[XB_TMO])) break; if (_sp > XB_SPIN_CAP) { atomicAdd(&(bar)[XB_TMO], 1u); break; } } } } while (0)

struct XcdBarrier {
    unsigned* bar; unsigned x;
    volatile LAS unsigned* st;
};

__device__ __forceinline__ XcdBarrier xcd_barrier_post(unsigned* bar, volatile LAS unsigned* st) {
    XcdBarrier b; b.bar = bar; b.x = xb_xcc_id(); b.st = st;
    if (ktid() == 0) st[2] = xb_add(&bar[XB_XCNT(b.x)], 1u);
    return b;
}
__device__ __forceinline__ void xcd_barrier_complete(unsigned* bar, unsigned x, unsigned& nloc, unsigned& nx) {
    const unsigned G = gridDim.x * gridDim.y * gridDim.z;
    unsigned sum, cnt, mine, sp = 0u;
    for (;;) {
        sum = 0u; cnt = 0u; mine = 0u;
#pragma unroll
        for (unsigned j = 0; j < 16; ++j) { const unsigned c = xb_ld(&bar[XB_XCNT(j)]); sum += c; cnt += (c > 0u) ? 1u : 0u; mine = (j == x) ? c : mine; }
        if (sum == G) break;
        __builtin_amdgcn_s_sleep(1);
        if ((++sp & 255u) == 0u) { if (xb_ld(&bar[XB_TMO])) break; if (sp > XB_SPIN_CAP) { atomicAdd(&bar[XB_TMO], 1u); break; } }
    }
    nloc = mine > 0u ? mine : 1u; nx = cnt > 0u ? cnt : 1u;
}

__device__ __forceinline__ void xcd_barrier(const XcdBarrier& b) {
    asm volatile("s_waitcnt vmcnt(0)" ::: "memory");
    __syncthreads();
    if (ktid() == 0) {
        unsigned* bar = b.bar;
        __builtin_amdgcn_s_waitcnt(0);
        unsigned nloc = b.st[0], nx = b.st[1];
        if (nloc == 0u) { xcd_barrier_complete(bar, b.x, nloc, nx); b.st[0] = nloc; b.st[1] = nx; }
        const unsigned old = xb_add(&bar[XB_XSUB(b.x)], 1u);
        const unsigned gen = old / nloc;
        if (old + 1u == (gen + 1u) * nloc) {
            __builtin_amdgcn_fence(__ATOMIC_RELEASE, "agent");
            asm volatile("s_waitcnt vmcnt(0)" ::: "memory");
            const unsigned og = xb_add(&bar[XB_TOP], 1u);
            const unsigned tg = og / nx;
            if (og + 1u == (tg + 1u) * nx) xb_add(&bar[XB_TOPGEN], 1u);
            else XB_SPIN(xb_ld(&bar[XB_TOPGEN]) == tg, bar);
            __builtin_amdgcn_fence(__ATOMIC_ACQUIRE, "agent");
            xb_add(&bar[XB_XGEN(b.x)], 1u);
            asm volatile("s_waitcnt vmcnt(0)" ::: "memory");
        } else {
            XB_SPIN(xb_ld(&bar[XB_XGEN(b.x)]) == gen, bar);
            __builtin_amdgcn_fence(__ATOMIC_ACQUIRE, "agent");
            asm volatile("s_waitcnt vmcnt(0)" ::: "memory");
        }
    }
    __syncthreads();
}

#define XB_LSUB(j)  (3520 + 64 * (j))
#define XB_LGEN(j)  (4608 + 64 * (j))
__device__ __forceinline__ void xcd_local_barrier(const XcdBarrier& b, unsigned nloc) {
    asm volatile("s_waitcnt vmcnt(0)" ::: "memory");
    __syncthreads();
    if (ktid() == 0) { unsigned* bar = b.bar;
        const unsigned old = xb_add(&bar[XB_LSUB(b.x)], 1u), gen = old / nloc;
        if (old + 1u == (gen + 1u) * nloc) xb_add(&bar[XB_LGEN(b.x)], 1u);
        else XB_SPIN(xb_ld(&bar[XB_LGEN(b.x)]) == gen, bar);
        __builtin_amdgcn_fence(__ATOMIC_ACQUIRE, "agent"); asm volatile("s_waitcnt vmcnt(0)" ::: "memory"); }
    __syncthreads();
}
__device__ __forceinline__ void g1_mid_barrier(unsigned* barw, unsigned x) { XcdBarrier b; b.bar = barw; b.x = x; b.st = nullptr; xcd_local_barrier(b, 32u); }
#define XB_L2SUB(j)  (5184 + 64 * (j))
#define XB_L2GEN(j)  (5760 + 64 * (j))
__device__ __forceinline__ void xcd_sub_barrier(const XcdBarrier& b, unsigned nsub) {
    asm volatile("s_waitcnt vmcnt(0)" ::: "memory");
    __syncthreads();
    if (ktid() == 0) { unsigned* bar = b.bar;
        const unsigned old = xb_add(&bar[XB_L2SUB(b.x)], 1u), gen = old / nsub;
        if (old + 1u == (gen + 1u) * nsub) xb_add(&bar[XB_L2GEN(b.x)], 1u);
        else XB_SPIN(xb_ld(&bar[XB_L2GEN(b.x)]) == gen, bar);
        __builtin_amdgcn_fence(__ATOMIC_ACQUIRE, "agent"); asm volatile("s_waitcnt vmcnt(0)" ::: "memory"); }
    __syncthreads();
}
struct Args { const void* in[28]; float* out; unsigned char* ws; int ph_lo, ph_hi; };
enum { I_X = 0, I_C, I_CTX, I_CCTX, I_WMOD, I_BMOD, I_GNORM, I_WIN, I_WOUT, I_DLAM, I_DSUBLN, I_GQN, I_GKN, I_GON, I_HCW, I_HCB, I_HW1, I_HB1, I_HW2, I_HB2, I_HW3, I_HB3, I_HWOUT, I_HFREQ, I_HBIAS, I_HON, I_WUP, I_WDN };

DI void p0_transpose_item(const float* __restrict__ W, int K, int N, u16* __restrict__ WT, LAS float* scr, int item, int lane) {
    const int nblk = N / 64, kb = item / nblk, nb = item - kb * nblk, k0 = 64 * kb, n0 = 64 * nb;
    const int kr = lane >> 4, nc = lane & 15;
    f32x4 v[16];
#pragma unroll
    for (int i = 0; i < 16; ++i) v[i] = __builtin_nontemporal_load((const f32x4*)(W + (size_t)(k0 + 4 * i + kr) * N + n0 + 4 * nc));
#pragma unroll
    for (int i = 0; i < 16; ++i) { LAS float* s = scr + (4 * i + kr) * 65 + 4 * nc; s[0] = v[i].x; s[1] = v[i].y; s[2] = v[i].z; s[3] = v[i].w; }
    LDS_WAIT(); asm volatile("" ::: "memory");
    const int nr = lane >> 3, kc = lane & 7;
#pragma unroll
    for (int it = 0; it < 8; ++it) { const int n = 8 * it + nr; const LAS float* s = scr + (8 * kc) * 65 + n;
        u32x4 o; o.x = pk2(s[0 * 65], s[1 * 65]); o.y = pk2(s[2 * 65], s[3 * 65]); o.z = pk2(s[4 * 65], s[5 * 65]); o.w = pk2(s[6 * 65], s[7 * 65]);
        __builtin_nontemporal_store(o, (u32x4*)(WT + (size_t)(n0 + n) * K + k0 + 8 * kc)); }
    LDS_WAIT(); asm volatile("" ::: "memory");
}
DI void p0_weights(const Args& a, LAS unsigned char* lds, int vcu, int G, int l_lo, int l_hi) {
    const int tid = opaque_tid(), lane = tid & 63, wave = __builtin_amdgcn_readfirstlane(tid >> 6), gw = vcu * NWAVES + wave, NGW = G * NWAVES;
    LAS float* scr = (LAS float*)(lds + wave * 16640);
    constexpr int I_IN = (DM / 64) * (NIN / 64), I_OUT = (DM / 64) * (DM / 64), I_UP = (DM / 64) * (DFF / 64), I_DN = (DFF / 64) * (DM / 64), PER = I_IN + I_OUT + I_UP + I_DN;
    for (int it = gw; it < (l_hi - l_lo) * PER; it += NGW) {
        const int l = l_lo + it / PER; int r = it - (l - l_lo) * PER;
        if (r < I_IN) { p0_transpose_item((const float*)a.in[I_WIN] + (size_t)l * DM * NIN, DM, NIN, (u16*)(a.ws + WS_WIN) + (size_t)l * NIN * DM, scr, r, lane); continue; } r -= I_IN;
        if (r < I_OUT) { p0_transpose_item((const float*)a.in[I_WOUT] + (size_t)l * DM * DM, DM, DM, (u16*)(a.ws + WS_WOUT) + (size_t)l * DM * DM, scr, r, lane); continue; } r -= I_OUT;
        if (r < I_UP) { p0_transpose_item((const float*)a.in[I_WUP] + (size_t)l * DM * DFF, DM, DFF, (u16*)(a.ws + WS_WUP) + (size_t)l * DFF * DM, scr, r, lane); continue; } r -= I_UP;
        p0_transpose_item((const float*)a.in[I_WDN] + (size_t)l * DFF * DM, DFF, DM, (u16*)(a.ws + WS_WDN) + (size_t)l * DM * DFF, scr, r, lane);
    }
}
DI void p0_mod(const Args& a, LAS unsigned char* lds, int blk, int G) {
    const int tid = opaque_tid(), lane = tid & 63, wave = __builtin_amdgcn_readfirstlane(tid >> 6);
    const float* c = (const float*)a.in[I_C]; const float* cc = (const float*)a.in[I_CCTX];
    const float* wmod = (const float*)a.in[I_WMOD]; const float* bmod = (const float*)a.in[I_BMOD]; const float* gn = (const float*)a.in[I_GNORM];
    float* modv = (float*)(a.ws + WS_MODV);
    LAS float* part = (LAS float*)lds;
    const int k0 = wave * 256, li = lane & 31, kg = lane >> 5;
    bf16x8 af[16];
#pragma unroll
    for (int ks = 0; ks < 16; ++ks) { const int k = k0 + 16 * ks + 8 * kg;
        f32x4 x0 = {0.f, 0.f, 0.f, 0.f}, x1 = x0;
        if (li < 17) { const float* sp = (li < 16) ? c + li * DM + k : cc + k; x0 = *(const f32x4*)sp; x1 = *(const f32x4*)(sp + 4); }
        float v[8] = {x0[0], x0[1], x0[2], x0[3], x1[0], x1[1], x1[2], x1[3]};
#pragma unroll
        for (int j = 0; j < 8; ++j) v[j] = v[j] / (1.0f + expf(-v[j]));
        u32x4 w; w.x = pk2(v[0], v[1]); w.y = pk2(v[2], v[3]); w.z = pk2(v[4], v[5]); w.w = pk2(v[6], v[7]); af[ks] = __builtin_bit_cast(bf16x8, w); }
    constexpr unsigned ROWB = NMOD * DM * 4;
    for (int item = blk; item < NLAYER * 192; item += G) {
        const int l = item / 192, nb = item - l * 192, n = 64 * nb + lane;
        const char* wl = (const char*)(wmod + (size_t)l * DM * (NMOD * DM));
        const unsigned voff = (unsigned)(k0 + 8 * kg) * ROWB + (unsigned)(64 * nb + 2 * li) * 4u;
        f32x16 acc0 = {}, acc1 = {};
        float wa[2][16], wb[2][16];
#define MOD_LOADG(buf, g) do { _Pragma("unroll") for (int kk = 0; kk < 2; ++kk) _Pragma("unroll") for (int j = 0; j < 8; ++j) { const char* rp = wl + (size_t)((16 * (2 * (g) + kk) + j)) * ROWB;   \
            const f32x2 v2_ = __builtin_nontemporal_load((const f32x2*)(rp + voff)); buf[0][kk * 8 + j] = v2_.x; buf[1][kk * 8 + j] = v2_.y; } } while (0)
#define MOD_MULG(buf, g) do { _Pragma("unroll") for (int kk = 0; kk < 2; ++kk) { u32x4 b0, b1;                                                                                         \
            b0.x = pk2(buf[0][kk * 8 + 0], buf[0][kk * 8 + 1]); b0.y = pk2(buf[0][kk * 8 + 2], buf[0][kk * 8 + 3]); b0.z = pk2(buf[0][kk * 8 + 4], buf[0][kk * 8 + 5]); b0.w = pk2(buf[0][kk * 8 + 6], buf[0][kk * 8 + 7]); \
            b1.x = pk2(buf[1][kk * 8 + 0], buf[1][kk * 8 + 1]); b1.y = pk2(buf[1][kk * 8 + 2], buf[1][kk * 8 + 3]); b1.z = pk2(buf[1][kk * 8 + 4], buf[1][kk * 8 + 5]); b1.w = pk2(buf[1][kk * 8 + 6], buf[1][kk * 8 + 7]); \
            acc0 = __builtin_amdgcn_mfma_f32_32x32x16_bf16(af[2 * (g) + kk], __builtin_bit_cast(bf16x8, b0), acc0, 0, 0, 0);                                                           \
            acc1 = __builtin_amdgcn_mfma_f32_32x32x16_bf16(af[2 * (g) + kk], __builtin_bit_cast(bf16x8, b1), acc1, 0, 0, 0); } } while (0)
        MOD_LOADG(wa, 0);
#pragma unroll
        for (int g = 0; g < 8; g += 2) {
            MOD_LOADG(wb, g + 1); __builtin_amdgcn_sched_barrier(0);
            MOD_MULG(wa, g); __builtin_amdgcn_sched_barrier(0);
            if (g + 2 < 8) { MOD_LOADG(wa, g + 2); } __builtin_amdgcn_sched_barrier(0);
            MOD_MULG(wb, g + 1); __builtin_amdgcn_sched_barrier(0);
        }
#undef MOD_LOADG
#undef MOD_MULG
#pragma unroll
        for (int r = 0; r < 9; ++r) { const int i = (r & 3) + 8 * (r >> 2) + 4 * kg;
            if (r < 8 || kg == 0) { part[(wave * 17 + i) * 64 + 2 * li] = acc0[r]; part[(wave * 17 + i) * 64 + 2 * li + 1] = acc1[r]; } }
        __syncthreads();
        for (int i = wave; i < 17; i += 8) {
            float s = 0.f;
#pragma unroll
            for (int w = 0; w < 8; ++w) s += part[(w * 17 + i) * 64 + lane];
            s += bmod[l * (NMOD * DM) + n];
            const int chunk = n / DM, col = n - chunk * DM;
            float v = s;
            if (chunk == 1) v = gn[(l * 4 + 0) * DM + col] * (1.0f + s);
            else if (chunk == 2) v = gn[(l * 4 + 1) * DM + col] * s;
            else if (chunk == 4) v = gn[(l * 4 + 2) * DM + col] * (1.0f + s);
            else if (chunk == 5) v = gn[(l * 4 + 3) * DM + col] * s;
            modv[((size_t)(l * 17 + i) * NMOD + chunk) * DM + col] = v;
        }
        __syncthreads();
    }
}
DI void p0_filters(const Args& a, LAS unsigned char* lds, int blk, int G, int l_lo, int l_hi) {
    const int tid = opaque_tid(), lane = tid & 63, wave = __builtin_amdgcn_readfirstlane(tid >> 6);
    const float* w1 = (const float*)a.in[I_HW1]; const float* b1 = (const float*)a.in[I_HB1]; const float* w2 = (const float*)a.in[I_HW2]; const float* b2 = (const float*)a.in[I_HB2];
    const float* w3 = (const float*)a.in[I_HW3]; const float* b3 = (const float*)a.in[I_HB3]; const float* wout = (const float*)a.in[I_HWOUT]; const float* fr = (const float*)a.in[I_HFREQ];
    const float* hbias = (const float*)a.in[I_HBIAS];
    LAS float* hs = (LAS float*)lds;
    for (int it = blk; it < (l_hi - l_lo) * 36; it += G) {
        const int l = l_lo + it / 36; int pbk = it - (l - l_lo) * 36; asm volatile("" : "+s"(pbk));
        const bool isctx = pbk >= 32; const int n = isctx ? CTXL : SEQ, i0 = 64 * (isctx ? pbk - 32 : pbk);
        u16* kf = isctx ? (u16*)(a.ws + WS_KFC) + (size_t)l * 512 * 512 : (u16*)(a.ws + WS_KFL) + (size_t)l * 512 * 4096;
#pragma unroll 1
        for (int p = 0; p < 8; ++p) {
            const int i = i0 + 8 * wave + p; const float rn1 = isctx ? (1.0f / (float)(CTXL - 1)) : (1.0f / (float)(SEQ - 1)), rn = isctx ? (6.283185307179586f / (float)CTXL) : (6.283185307179586f / (float)SEQ);
            const float t = (float)i * rn1, w = (float)i * rn;
            float zk = 0.f;
            if (lane == 0) zk = t;
            else if (lane < 17) { const float f = 1e-4f + (float)(lane - 1) * ((15.0f - 1e-4f) / 15.0f); zk = cosf(f * w); }
            else if (lane < 33) { const float f = 1e-4f + (float)(lane - 17) * ((15.0f - 1e-4f) / 15.0f); zk = -sinf(f * w); }
            float s = b1[l * 64 + lane];
#pragma unroll
            for (int k = 0; k < 33; ++k) s = fmaf(rdlane(zk, k), w1[(l * 33 + k) * 64 + lane], s);
            float h = sinf(fr[(l * 3 + 0) * 64 + lane] * s);
            s = b2[l * 64 + lane];
#pragma unroll 16
            for (int k = 0; k < 64; ++k) s = fmaf(rdlane(h, k), w2[(l * 64 + k) * 64 + lane], s);
            h = sinf(fr[(l * 3 + 1) * 64 + lane] * s);
            s = b3[l * 64 + lane];
#pragma unroll 16
            for (int k = 0; k < 64; ++k) s = fmaf(rdlane(h, k), w3[(l * 64 + k) * 64 + lane], s);
            hs[(8 * wave + p) * 65 + lane] = sinf(fr[(l * 3 + 2) * 64 + lane] * s);
        }
        __syncthreads();
        const int pl = lane & 31, kg = lane >> 5;
        const float rn1o = isctx ? (1.0f / (float)(CTXL - 1)) : (1.0f / (float)(SEQ - 1));
        const float min_decay = -4.605170185988091f / 1.5f, max_decay = -4.605170185988091f / 0.3f;
        bf16x8 bh[2][4], bl[2][4];
#pragma unroll
        for (int bb = 0; bb < 2; ++bb)
#pragma unroll
            for (int ks = 0; ks < 4; ++ks) { const LAS float* hp = hs + (32 * bb + pl) * 65 + 16 * ks + 8 * kg; u32x4 h, lo;
#pragma unroll
                for (int q = 0; q < 4; ++q) { const float x0 = hp[2 * q], x1 = hp[2 * q + 1]; const unsigned w = pk2(x0, x1); h[q] = w; lo[q] = pk2(x0 - bflo(w), x1 - bfhi(w)); }
                bh[bb][ks] = __builtin_bit_cast(bf16x8, h); bl[bb][ks] = __builtin_bit_cast(bf16x8, lo); }
        const bool back = wave >= 4;
#pragma unroll 1
        for (int ab = 0; ab < 4; ++ab) {
            const int cc0 = 128 * wave + 32 * ab;
            bf16x8 ah[4], al[4];
#pragma unroll
            for (int ks = 0; ks < 4; ++ks) { const float* wp = wout + (size_t)(l * 64 + 16 * ks + 8 * kg) * 1024 + cc0 + pl; u32x4 h, lo;
#pragma unroll
                for (int q = 0; q < 4; ++q) { const float x0 = wp[(2 * q) * 1024], x1 = wp[(2 * q + 1) * 1024]; const unsigned w = pk2(x0, x1); h[q] = w; lo[q] = pk2(x0 - bflo(w), x1 - bfhi(w)); }
                ah[ks] = __builtin_bit_cast(bf16x8, h); al[ks] = __builtin_bit_cast(bf16x8, lo); }
#pragma unroll
            for (int bb = 0; bb < 2; ++bb) {
                f32x16 acc = {};
#pragma unroll
                for (int ks = 0; ks < 4; ++ks) { acc = __builtin_amdgcn_mfma_f32_32x32x16_bf16(al[ks], bh[bb][ks], acc, 0, 0, 0); acc = __builtin_amdgcn_mfma_f32_32x32x16_bf16(ah[ks], bl[bb][ks], acc, 0, 0, 0);
                    acc = __builtin_amdgcn_mfma_f32_32x32x16_bf16(ah[ks], bh[bb][ks], acc, 0, 0, 0); }
                const int i = i0 + 32 * bb + pl; const float tt = (float)i * rn1o;
#pragma unroll
                for (int r = 0; r < 16; ++r) { const int cc = cc0 + (r & 3) + 8 * (r >> 2) + 4 * kg, ch = cc & 511;
                    const float ad = fabsf(min_decay + (float)ch * ((max_decay - min_decay) / 511.0f));
                    float v = acc[r] * expf(-tt * ad);
                    u16* kc = kf + (size_t)ch * (2 * n);
                    if (!back) { if (i == 0) v += hbias[l * 512 + ch]; kc[n + i] = tobf(v); }
                    else { if (i == 0) kc[0] = 0; else kc[n - i] = tobf(v); } }
            }
        }
        __syncthreads();
    }
}
DI void p0_rope(const Args& a, int blk, int G) {
    const int gt = blk * (NWAVES * 64) + opaque_tid(), NGT = G * NWAVES * 64;
    f32x2* rd = (f32x2*)(a.ws + WS_ROPED); f32x2* rg = (f32x2*)(a.ws + WS_ROPEG);
    for (int e = gt; e < SEQ * 96; e += NGT) {
        const int t = e / 96, p = e - t * 96; const float trow = (float)(t >> 6), tcol = (float)(t & 63);
        if (p < 32) { const int k = p & 15; const float inv = powf(10000.0f, -(float)(2 * k) / 32.0f), ang = (p < 16 ? trow : tcol) * inv; rd[t * 32 + p] = (f32x2){cosf(ang), sinf(ang)}; }
        else { const int pp = p - 32, k = pp & 31; const float inv = powf(10000.0f, -(float)(2 * k) / 64.0f), ang = (pp < 32 ? trow : tcol) * inv; rg[t * 64 + pp] = (f32x2){cosf(ang), sinf(ang)}; }
    }
}

template <int MODE, bool FROM_IN = false>
DI void tpass(const Args& a, LAS unsigned char* lds, int blk, int G, int l, int lA  , int cA, int cB, bool write_xn, int segmask  , int rb_lo = 0, int rb_hi = 256, bool out_f32 = false, size_t mixoff = WS_YB  , int xr0 = -1  , int xlen = 144) {
    const int tid = opaque_tid(), lane = tid & 63, wave = __builtin_amdgcn_readfirstlane(tid >> 6);
    const float* modv = (const float*)(a.ws + WS_MODV);
    u16* XN = (u16*)(a.ws + WS_XN); const u16* MIX = (const u16*)(a.ws + mixoff); const u16* YY = (const u16*)(a.ws + WS_CAT); u16* XS = (u16*)(a.ws + WS_XS);
    LAS f32x4* Gs = (LAS f32x4*)lds; LAS f32x4* As = (LAS f32x4*)(lds + 8192); LAS f32x4* Bs = (LAS f32x4*)(lds + 16384); LAS f32x4* G2s = (LAS f32x4*)(lds + 24576);
    constexpr bool fin = (MODE == 0) || FROM_IN;
    const int blen = xr0 >= 0 ? xlen : 144;
    for (int rb = xr0 >= 0 ? 0 : rb_lo + blk; rb < (xr0 >= 0 ? 1 : rb_hi); rb += G) {
        const int r0 = xr0 >= 0 ? xr0 : rb * 144, b = r0 / RPB, j0 = r0 - b * RPB;
#pragma unroll 1
        for (int seg = 0; seg < 2; ++seg) {
            const int ja = seg == 0 ? j0 : (j0 > CTXL ? j0 : CTXL), jb = seg == 0 ? (j0 + blen < CTXL ? j0 + blen : CTXL) : j0 + blen;
            if (ja >= jb || !((segmask >> seg) & 1)) continue;
            const int vi = seg == 0 ? 16 : b;
            __syncthreads();
            { const int t = wave * 64 + lane;
              if (MODE != 0) Gs[t] = *(const f32x4*)(modv + ((size_t)(l * 17 + vi) * NMOD + 2) * DM + 4 * t);
              if (MODE == 2) G2s[t] = *(const f32x4*)(modv + ((size_t)(l * 17 + vi) * NMOD + 5) * DM + 4 * t);
              if (write_xn) { As[t] = *(const f32x4*)(modv + ((size_t)(lA * 17 + vi) * NMOD + cA) * DM + 4 * t); Bs[t] = *(const f32x4*)(modv + ((size_t)(lA * 17 + vi) * NMOD + cB) * DM + 4 * t); } }
            __syncthreads();
#define TP_LOAD(jj) do { const unsigned ro_ = (unsigned)((b * RPB + (jj)) * (DM * 2)) + lane * 8u; \
                if (fin) { const char* xb0_ = (jj) < CTXL ? (const char*)a.in[I_CTX] : (const char*)a.in[I_X]; const unsigned xo_ = (unsigned)(((jj) < CTXL ? b * CTXL + (jj) : b * SEQ + ((jj) - CTXL)) * (DM * 4)) + lane * 16u; \
                    _Pragma("unroll") for (int q = 0; q < 8; ++q) xn_[q] = __builtin_nontemporal_load((const f32x4*)(xb0_ + xo_ + q * 1024)); } \
                else { _Pragma("unroll") for (int q = 0; q < 8; ++q) xb_[q] = __builtin_nontemporal_load((const u32x2*)((const char*)XS + ro_ + q * 512)); } \
                if (MODE != 0) { _Pragma("unroll") for (int q = 0; q < 8; ++q) mn_[q] = __builtin_nontemporal_load((const u32x2*)((const char*)MIX + ro_ + q * 512)); } \
                if (MODE == 2) { _Pragma("unroll") for (int q = 0; q < 8; ++q) yn_[q] = __builtin_nontemporal_load((const u32x2*)((const char*)YY + ro_ + q * 512)); } } while (0)
            f32x4 xn_[8]; u32x2 xb_[8]; u32x2 mn_[8]; u32x2 yn_[8];
            if (ja + wave < jb) TP_LOAD(ja + wave);
            for (int j = ja + wave; j < jb; j += NWAVES) {
                asm volatile("" ::: "memory");
                const unsigned ro = (unsigned)((b * RPB + j) * (DM * 2)) + lane * 8u;
                f32x4 xv[8]; u32x2 mw[8]; u32x2 yw[8];
#pragma unroll
                for (int q = 0; q < 8; ++q) { xv[q] = fin ? xn_[q] : (f32x4){bflo(xb_[q].x), bfhi(xb_[q].x), bflo(xb_[q].y), bfhi(xb_[q].y)}; mw[q] = mn_[q]; yw[q] = yn_[q]; }
                if (j + NWAVES < jb) TP_LOAD(j + NWAVES);
                if (MODE != 0) {
                    float ss = 0.f;
#pragma unroll
                    for (int q = 0; q < 8; ++q) { const float m0 = bflo(mw[q].x), m1 = bfhi(mw[q].x), m2 = bflo(mw[q].y), m3 = bfhi(mw[q].y); ss += (m0 * m0 + m1 * m1) + (m2 * m2 + m3 * m3); }
                    const float rs = frsq(wave_sum(ss) * (1.0f / DM) + EPS);
#pragma unroll
                    for (int q = 0; q < 8; ++q) xv[q] = xv[q] + Gs[lane + 64 * q] * (f32x4){bflo(mw[q].x), bfhi(mw[q].x), bflo(mw[q].y), bfhi(mw[q].y)} * rs;
                }
                if (MODE == 2) {
                    float ss = 0.f;
#pragma unroll
                    for (int q = 0; q < 8; ++q) { const float m0 = bflo(yw[q].x), m1 = bfhi(yw[q].x), m2 = bflo(yw[q].y), m3 = bfhi(yw[q].y); ss += (m0 * m0 + m1 * m1) + (m2 * m2 + m3 * m3); }
                    const float rs = frsq(wave_sum(ss) * (1.0f / DM) + EPS);
#pragma unroll
                    for (int q = 0; q < 8; ++q) xv[q] = xv[q] + G2s[lane + 64 * q] * (f32x4){bflo(yw[q].x), bfhi(yw[q].x), bflo(yw[q].y), bfhi(yw[q].y)} * rs;
                    if (out_f32) { const unsigned oo = (unsigned)((b * SEQ + (j - CTXL)) * (DM * 4)) + lane * 16u;
#pragma unroll
                        for (int q = 0; q < 8; ++q) __builtin_nontemporal_store(xv[q], (f32x4*)((char*)a.out + oo + q * 1024)); }
                    else {
#pragma unroll
                        for (int q = 0; q < 8; ++q) { u32x2 w; w.x = pk2(xv[q].x, xv[q].y); w.y = pk2(xv[q].z, xv[q].w); __builtin_nontemporal_store(w, (u32x2*)((char*)XS + ro + q * 512));
                            xv[q] = (f32x4){bflo(w.x), bfhi(w.x), bflo(w.y), bfhi(w.y)}; }
                    }
                }
                if (write_xn) {
                    float ss = 0.f;
#pragma unroll
                    for (int q = 0; q < 8; ++q) ss += (xv[q].x * xv[q].x + xv[q].y * xv[q].y) + (xv[q].z * xv[q].z + xv[q].w * xv[q].w);
                    const float rs = frsq(wave_sum(ss) * (1.0f / DM) + EPS);
#pragma unroll
                    for (int q = 0; q < 8; ++q) { const f32x4 o = xv[q] * rs * As[lane + 64 * q] + Bs[lane + 64 * q];
                        u32x2 w; w.x = pk2(o.x, o.y); w.y = pk2(o.z, o.w); *(u32x2*)((char*)XN + ro + q * 512) = w; }
                }
            }
#undef TP_LOAD
        }
    }
    __syncthreads();
}

DI void t3_hy(const Args& a, int l, LAS unsigned char* lds, int vcu, int G, bool last, int ownx = -1  , int nskip = 0  ) {
    const int tid = opaque_tid(), lane = tid & 63, wave = __builtin_amdgcn_readfirstlane(tid >> 6), gw = vcu * NWAVES + wave, NGW = G * NWAVES;
    const u16* H = (const u16*)(a.ws + WS_H); u16* X0 = (u16*)(a.ws + WS_X0); u16* ZT = (u16*)(a.ws + WS_ZT);
    const float* cw = (const float*)a.in[I_HCW] + (size_t)l * 3 * 1536; const float* cb = (const float*)a.in[I_HCB] + (size_t)l * 1536;
    constexpr int RS = 132;
    LAS unsigned char* tz = lds + wave * (64 * RS);
    const int rr = lane >> 3, ck = lane & 7;
    if (ownx >= 0 && vcu < nskip) return;
    const int it0 = ownx >= 0 ? 576 * ownx + gw - nskip * NWAVES : gw, it1 = ownx >= 0 ? 576 * ownx + 576 : (NROWS / 64) * 8, its = ownx >= 0 ? 256 - nskip * NWAVES : NGW;
    const int c = 64 * wave + 8 * ck;
    float w[3][3][8], bs[3][8];
#pragma unroll
    for (int set = 0; set < 3; ++set)
#pragma unroll
        for (int e = 0; e < 8; ++e) { const int col = 512 * set + c + e; w[set][0][e] = cw[col]; w[set][1][e] = cw[1536 + col]; w[set][2][e] = cw[3072 + col]; bs[set][e] = cb[col]; }
    for (int it = it0; it < it1; it += its) {
        const int rt = it >> 3, cgp = it & 7, b = rt / 36, j0 = (rt - b * 36) * 64;
        if (last && j0 < CTXL) continue;
        const int lo = j0 < CTXL ? 0 : CTXL, hiend = j0 < CTXL ? CTXL - 1 : RPB - 1;
#pragma unroll 2
        for (int g8 = 0; g8 < 8; ++g8) {
            const int j = j0 + 8 * g8 + rr; const bool hp = j > lo, hn = j < hiend;
            const u16* hr = H + ((size_t)b * RPB + j) * NIN + C_HY + c;
            float u[3][8];
#pragma unroll
            for (int set = 0; set < 3; ++set) {
                const u32x4 wc = *(const u32x4*)(hr + 512 * set);
                u32x4 wp = {0u, 0u, 0u, 0u}, wn = {0u, 0u, 0u, 0u};
                if (hp) wp = *(const u32x4*)(hr - NIN + 512 * set);
                if (hn) wn = *(const u32x4*)(hr + NIN + 512 * set);
#pragma unroll
                for (int e = 0; e < 8; ++e) { const float xp = (e & 1) ? bfhi(wp[e >> 1]) : bflo(wp[e >> 1]), xc = (e & 1) ? bfhi(wc[e >> 1]) : bflo(wc[e >> 1]), xn = (e & 1) ? bfhi(wn[e >> 1]) : bflo(wn[e >> 1]);
                    u[set][e] = w[set][0][e] * xp + w[set][1][e] * xc + w[set][2][e] * xn + bs[set][e]; }
            }
            u32x4 xo; LAS unsigned* pz = (LAS unsigned*)(tz + (8 * g8 + rr) * RS + 16 * ck);
#pragma unroll
            for (int e = 0; e < 4; ++e) { pz[e] = pk2(u[2][2 * e] * u[1][2 * e], u[2][2 * e + 1] * u[1][2 * e + 1]); xo[e] = pk2(u[0][2 * e], u[0][2 * e + 1]); }
            *(u32x4*)(X0 + ((size_t)b * RPB + j) * 512 + c) = xo;
        }
        LDS_WAIT(); asm volatile("" ::: "memory");
        { const int ch4 = lane >> 4, lq = lane & 15;
          const size_t ob = (size_t)b * RPB + j0 + 4 * lq;
#pragma unroll 8
          for (int cc = 0; cc < 64; cc += 4) { const int chl = cc + ch4; const LAS unsigned char* p = tz + (4 * lq) * RS + 2 * chl;
            const unsigned z0 = *(const LAS u16*)(p), z1 = *(const LAS u16*)(p + RS), z2 = *(const LAS u16*)(p + 2 * RS), z3 = *(const LAS u16*)(p + 3 * RS);
            u32x2 zz; zz.x = z0 | (z1 << 16); zz.y = z2 | (z3 << 16);
            *(u32x2*)(ZT + (size_t)(64 * cgp + chl) * NBATCH * RPB + ob) = zz; } }
        LDS_WAIT(); asm volatile("" ::: "memory");
    }
}
DI void t4_hy(const Args& a, int l, LAS unsigned char* lds, int blk, int G, bool last, int ownx = -1  ) {
    const int tid = opaque_tid(), lane = tid & 63, wave = __builtin_amdgcn_readfirstlane(tid >> 6);
    const u16* X0 = (const u16*)(a.ws + WS_X0); const u16* YT = (const u16*)(a.ws + WS_YT); u16* CAT = (u16*)(a.ws + WS_CAT);
    const float* hon = (const float*)a.in[I_HON] + l * 512;
    LAS float* tile = (LAS float*)(lds + wave * (64 * 65 * 4));
    LAS float* part = (LAS float*)(lds + 8 * (64 * 65 * 4));
    const int ch4 = lane >> 4, lq = lane & 15, rr = lane >> 3, ck = lane & 7;
    float hw[8];
#pragma unroll
    for (int e = 0; e < 8; ++e) hw[e] = hon[64 * wave + 8 * ck + e];
    const int rt0 = ownx >= 0 ? 72 * ownx + blk : blk, rt1 = ownx >= 0 ? 72 * ownx + 72 : NROWS / 64, rts = ownx >= 0 ? 32 : G;
    for (int rt = rt0; rt < rt1; rt += rts) {
        const int b = rt / 36, j0 = (rt - b * 36) * 64;
        if (last && j0 < CTXL) continue;
        u32x4 xw[8];
#pragma unroll
        for (int g8 = 0; g8 < 8; ++g8) xw[g8] = __builtin_nontemporal_load((const u32x4*)(X0 + ((size_t)b * RPB + j0 + 8 * g8 + rr) * 512 + 64 * wave + 8 * ck));
        { const size_t ob = (size_t)b * RPB + j0 + 4 * lq;
#pragma unroll 8
          for (int cc = 0; cc < 64; cc += 4) { const int chl = cc + ch4;
            const u32x2 yw = __builtin_nontemporal_load((const u32x2*)(YT + (size_t)(64 * wave + chl) * NBATCH * RPB + ob));
            LAS float* t = tile + (4 * lq) * 65 + chl; t[0] = bflo(yw.x); t[65] = bfhi(yw.x); t[130] = bflo(yw.y); t[195] = bfhi(yw.y); } }
        LDS_WAIT(); asm volatile("" ::: "memory");
        float o[8][8];
#pragma unroll
        for (int g8 = 0; g8 < 8; ++g8) { const int row = 8 * g8 + rr; const LAS float* t = tile + row * 65 + 8 * ck; float ss = 0.f;
#pragma unroll
            for (int e = 0; e < 8; ++e) { const float x0 = (e & 1) ? bfhi(xw[g8][e >> 1]) : bflo(xw[g8][e >> 1]); const float v = x0 * t[e]; o[g8][e] = v; ss += v * v; }
            ss = sum8(ss);
            if (ck == 0) part[wave * 64 + row] = ss; }
        __syncthreads();
#pragma unroll
        for (int g8 = 0; g8 < 8; ++g8) { const int row = 8 * g8 + rr;
            const float tot = sum8(part[ck * 64 + row]);
            const float rs = frsq(tot * (1.0f / 512.0f) + EPS); u32x4 wv;
#pragma unroll
            for (int e = 0; e < 4; ++e) wv[e] = pk2(o[g8][2 * e] * rs * hw[2 * e], o[g8][2 * e + 1] * rs * hw[2 * e + 1]);
            *(u32x4*)(CAT + ((size_t)b * RPB + j0 + row) * DM + 1536 + 64 * wave + 8 * ck) = wv; }
        __syncthreads();
    }
    __syncthreads();
}
DI void mixer_phase(const Args& a, int l, char* ldsg, int vcu, int G, bool last) {
    const int lane = opaque_tid() & 63;
    const u16* H = (const u16*)(a.ws + WS_H); u16* CAT = (u16*)(a.ws + WS_CAT);
#ifndef MIXMASK
#define MIXMASK 7
#endif
    if (MIXMASK & 1) { const float* gon = (const float*)a.in[I_GON] + l * 128;
      const int nun = last ? 1024 : 1152;
      for (int u = vcu; u < nun; u += G) {
        int b, hq, row0, seq;
        if (u < 1024) { b = u >> 6; hq = ((u >> 5) & 1) * 4 + ((u >> 3) & 3); row0 = b * RPB + CTXL + (u & 7) * 256; seq = RPB; }
        else { const int v = u - 1024; b = v >> 3; hq = v & 7; row0 = b * RPB; seq = CTXL; }
        const int kvh = hq >> 2; const size_t kv0 = (size_t)b * RPB * NIN;
        att::attn_unit<0>(H + (size_t)row0 * NIN + C_GQ + hq * 128, H + kv0 + C_GK + kvh * 128, H + kv0 + C_GV + kvh * 128, seq, ldsg, CAT + (size_t)row0 * DM + 512 + hq * 128, gon, 0.f, 1.f);
      } }
    if (MIXMASK & 2) { const float* dl = (const float*)a.in[I_DLAM] + l * 256; const float* subln = (const float*)a.in[I_DSUBLN] + l * 128;
      const float lam_init = 0.8f - 0.6f * expf(-0.3f * (float)l);
      const float lam = expf(wave_sum(dl[lane] * dl[64 + lane])) - expf(wave_sum(dl[128 + lane] * dl[192 + lane])) + lam_init;
      const int nun = last ? 1024 : 1152;
      for (int u = vcu; u < nun; u += G) {
        int b, h, row0, seq;
        if (u < 1024) { b = u >> 6; h = (u >> 4) & 3; row0 = b * RPB + CTXL + (u & 15) * 128; seq = RPB; }
        else { const int v = u - 1024; b = v >> 3; h = (v >> 1) & 3; row0 = b * RPB + (v & 1) * 128; seq = CTXL; }
        const size_t kv0 = (size_t)b * RPB * NIN;
        att::attn_unit<1>(H + (size_t)row0 * NIN + C_DQ + h * 128, H + kv0 + C_DK + h * 128, H + kv0 + C_DV + h * 128, seq, ldsg, CAT + (size_t)row0 * DM + h * 128, subln, lam, 1.0f - lam_init);
      } }
    if (MIXMASK & 4) { const u16* ZT = (const u16*)(a.ws + WS_ZT); u16* YT = (u16*)(a.ws + WS_YT);
      const u16* KFL = (const u16*)(a.ws + WS_KFL) + (size_t)l * 512 * 4096; const u16* KFC = (const u16*)(a.ws + WS_KFC) + (size_t)l * 512 * 512;
      for (int c = vcu; c < 512; c += G) hyena_unit<SEQ>(KFL + (size_t)c * 4096, ZT + (size_t)c * NBATCH * RPB + CTXL, YT + (size_t)c * NBATCH * RPB + CTXL, ldsg);
      if (!last) {
        const int w0 = (G == 256) ? (vcu >= 128 ? vcu - 128 : 512) : vcu, ws = (G == 256) ? 128 : G;
        for (int c = w0; c < 512; c += ws) hyena_unit<CTXL>(KFC + (size_t)c * 512, ZT + (size_t)c * NBATCH * RPB, YT + (size_t)c * NBATCH * RPB, ldsg); }
    }
}

#ifndef REP_P0
#define REP_P0 1
#endif
#ifndef REP_GEMM
#define REP_GEMM 1
#endif
#ifndef REP_MIX
#define REP_MIX 1
#endif
#ifndef REP_THY
#define REP_THY 1
#endif
#ifndef REP_T12
#define REP_T12 0
#endif
#ifndef REP_BAR
#define REP_BAR 1
#endif
#ifndef REP_W
#define REP_W 1
#endif
#define HOSTED false
#ifndef PHMASK
#define PHMASK 0xffff
#endif
#define EN(x) (((PHMASK) >> (x)) & 1)
constexpr int MLP_CH = 32  , NCHUNK = 5, PPL = 16, NPHASE = 2 + NLAYER * PPL;
__global__ void __launch_bounds__(NWAVES * 64, 2) fwd_kernel(Args args) {
    LAS unsigned char* lds = (LAS unsigned char*)lds_raw;
    volatile LAS unsigned* MISC = (volatile LAS unsigned*)(lds + MISC_OFF);
    const int tid = threadIdx.x;
    const int G = gridDim.x, blk = blockIdx.x;
    const int vcu = (G % 8 == 0) ? (blk % 8) * (G / 8) + blk / 8 : blk;
    gu32* ctl = (gu32*)(args.ws + WS_CTL);
    for (int u = tid; u < (LDS_BYTES - LDSCTL_OFF) / 4; u += NWAVES * 64) ((LAS unsigned*)(lds + LDSCTL_OFF))[u] = 0u;
    __syncthreads();
    if ((tid & 63) == 0) ((volatile LAS unsigned*)(lds + WTAB_OFF))[hw_wave_slot()] = (unsigned)(tid >> 6);
    __syncthreads();
    const bool multi = (args.ph_hi - args.ph_lo) > 1;
    XcdBarrier bar; bar.bar = (unsigned*)(ctl + CW_BAR); bar.x = 0; bar.st = nullptr;
    if (multi) bar = xcd_barrier_post((unsigned*)(ctl + CW_BAR), MISC + 8);
#define PH(k) (args.ph_lo <= (k) && (k) < args.ph_hi)
#define SEAM(k) do { if (PH(k) && PH((k) + 1)) for (int rep_ = 0; rep_ < REP_BAR; ++rep_) xcd_barrier(bar); } while (0)
    u16* const XN = (u16*)(args.ws + WS_XN); u16* const HB = (u16*)(args.ws + WS_H); u16* const CAT = (u16*)(args.ws + WS_CAT); u16* const YB = (u16*)(args.ws + WS_YB);

    if (EN(0) && PH(0)) for (int rep = 0; rep < REP_P0; ++rep) {
        __syncthreads();
        for (int rw = 0; rw < REP_W; ++rw) { __syncthreads(); p0_weights(args, lds, vcu, G, 0, HOSTED ? 1 : NLAYER); }
        __syncthreads();
        p0_mod(args, lds, blk, G);
        __syncthreads();
        p0_filters(args, lds, blk, G, 0, HOSTED ? 1 : NLAYER);
        p0_rope(args, blk, G);
    }
    SEAM(0);
    int cb = blk; bool lsync = false;
    if (multi && G == 256) { unsigned okc = 1u;
#pragma unroll
        for (unsigned j = 0; j < 16; ++j) { const unsigned cj = xb_ld((unsigned*)(ctl + CW_BAR) + XB_XCNT(j)); okc &= (j < 8 ? cj == 32u : cj == 0u) ? 1u : 0u; }
        if (__builtin_amdgcn_readfirstlane(okc)) { lsync = true; cb = __builtin_amdgcn_readfirstlane((int)(MISC[10] * 8u + bar.x)); } }
    size_t hid_off = WS_H, yb_off = WS_YB;
    if (lsync) { const size_t x_ = (size_t)(cb & 7), XB_ = (size_t)4608 * NIN * 2;
        hid_off = WS_H + XB_ * x_ - (4 * x_) * ((size_t)256 * DFF * 2);
        yb_off = WS_H + XB_ * x_ + ((size_t)16 << 20) - (4608 * x_) * ((size_t)DM * 2); }
    const int tb = lsync ? (cb & 7) * 32 + (cb >> 3) : blk;
    if (EN(1) && PH(1)) tpass<0>(args, lds, tb, G, 0, 0, 1, 0, true, 3);
    if (lsync) { if (PH(1) && PH(2)) xcd_local_barrier(bar, 32u); } else SEAM(1);
#pragma unroll 1
    for (int l = 0; l < NLAYER; ++l) {
        const int p0 = 2 + l * PPL; const bool last = (l == NLAYER - 1);
        const int npan = last ? 128 : 144;
        if (EN(2) && PH(p0)) {
            pg8::Gemm g{XN, (const u16*)(args.ws + WS_WIN) + (size_t)l * NIN * DM, NROWS, NIN, DM};
            pg8::PanelSched S; S.so.init(NROWS, NIN, G, lsync ? cb : blk); S.base = 0; S.latent_only = false; S.a_local = false; S.o_local = false; S.deal = lsync ? 6 : 0; const bool mid = lsync && !last; if (mid) { S.midbar = bar.bar; S.midx = bar.x; }
            if (last && G == 256) { S.so.init(128 * 256, NIN, G, lsync ? cb : blk); S.latent_only = true; S.deal = 2; S.ctxown = lsync; if (lsync) { S.midbar = bar.bar; S.midx = bar.x; } }
            pg8::EpiQK E{HB, NIN, (const f32x2*)(args.ws + WS_ROPED), (const f32x2*)(args.ws + WS_ROPEG), (const float*)args.in[I_GQN] + l * 128, (const float*)args.in[I_GKN] + l * 128, (LAS float*)(lds + 131072)};
            pg8::gemm_phase<pg8::EpiQK, pg8::PanelSched, true, true>(lds, g, S, E);
            if (HOSTED && !last && blk >= 32) { __syncthreads(); p0_weights(args, lds, blk - 32, 224, l + 1, l + 2); }
        }
        if (lsync) { if (PH(p0) && PH(p0 + 1) && !((cb >> 3) < (last ? 12 : 4))) xcd_local_barrier(bar, 32u); } else SEAM(p0);
        if (EN(3) && PH(p0 + 1)) { for (int rep = 0; rep < REP_THY; ++rep) { if (lsync) t3_hy(args, l, lds, cb >> 3, G, last, cb & 7, last ? 12 : 4); else t3_hy(args, l, lds, vcu, G, last); } }
        SEAM(p0 + 1);
        if (EN(4) && PH(p0 + 2)) for (int rep = 0; rep < REP_MIX; ++rep) mixer_phase(args, l, (char*)lds_raw, vcu, G, last);
        SEAM(p0 + 2);
        if (EN(5) && PH(p0 + 3)) for (int rep = 0; rep < REP_THY; ++rep) { if (lsync) t4_hy(args, l, lds, cb >> 3, G, last, cb & 7); else t4_hy(args, l, lds, blk, G, last); }
        if (lsync) { if (PH(p0 + 3) && PH(p0 + 4)) xcd_local_barrier(bar, 32u); } else SEAM(p0 + 3);
        if (EN(6) && PH(p0 + 4)) {
            pg8::Gemm g{CAT, (const u16*)(args.ws + WS_WOUT) + (size_t)l * DM * DM, npan * 256, DM, DM};
            pg8::PanelSched S; S.so.init(npan * 256, DM, G, lsync ? cb : blk); S.base = 0; S.latent_only = last; S.a_local = false; S.o_local = false; S.deal = (lsync && !last) ? 5 : 0; if (lsync && !last) { S.midbar = bar.bar; S.midx = bar.x; }
            pg8::EpiStore<0> E{(u16*)(args.ws + yb_off), DM};
            for (int rep = 0; rep < REP_GEMM; ++rep) pg8::gemm_phase<pg8::EpiStore<0>, pg8::PanelSched, true, true>(lds, g, S, E);
            if (HOSTED && !last && blk >= 128) { __syncthreads(); p0_filters(args, lds, blk - 128, 128, l + 1, l + 2); }
        }
        const bool g2mid = lsync && !last;
        if (lsync) { if (PH(p0 + 4) && PH(p0 + 5)) { if (!g2mid || (cb >> 3) >= 16) xcd_local_barrier(bar, 32u); else xcd_sub_barrier(bar, 16u); } } else SEAM(p0 + 4);
        if (EN(7) && PH(p0 + 5)) { int xr0 = -1, xl = 144;
            if (g2mid) { const int x_ = cb & 7, rk_ = cb >> 3; if (rk_ >= 16) { xr0 = 4608 * x_ + 256 * (rk_ - 16); xl = 256; } else { xr0 = 4608 * x_ + 4096 + 32 * rk_; xl = 32; } }
            if (l == 0) tpass<1, true>(args, lds, tb, G, l, l, 4, 3, true, 3, 0, 256, false, yb_off, xr0, xl); else tpass<1>(args, lds, tb, G, l, l, 4, 3, true, last ? 2 : 3, 0, 256, false, yb_off, xr0, xl); }
        if (lsync) { if (PH(p0 + 5) && PH(p0 + 6)) xcd_local_barrier(bar, 32u); } else SEAM(p0 + 5);
#pragma unroll 1
        for (int s = 0; s <= 8; ++s) {
            if (PH(p0 + 6 + s)) {
                int dpb = 0, dnp = 0; bool dR = false;
                if (s == 1) { if (!last) { dpb = 128; dnp = 16; dR = true; } } else if (s >= 2 && (s & 1) == 0) { dpb = 32 * ((s - 2) >> 1); dnp = 32; }
                if (EN(9) && dnp > 0) {
                    pg8::Gemm g{(const u16*)(args.ws + (dR ? WS_HIDR : hid_off)), (const u16*)(args.ws + WS_WDN) + (size_t)l * DM * DFF, dnp * 256, DM, DFF};
                    pg8::PanelSched S; S.so.init(dnp * 256, DM, G, cb); S.base = dpb; S.latent_only = last; S.a_local = true; S.o_local = false; S.deal = 0; S.own = lsync; if (lsync && dR) S.so.wgm = 2;
                    pg8::EpiStore<0> E{CAT, DM};
                    pg8::gemm_phase<pg8::EpiStore<0>, pg8::PanelSched, true, true>(lds, g, S, E);
                }
                int upb = 0, unp = 0, deal = 0; bool uR = false;
                if (s == 0) { if (!last) { upb = 128; unp = 16; uR = true; } } else if (s & 1) { upb = 32 * ((s - 1) >> 1); unp = 32; if (s == 1 && !last && G == 256) deal = 1; }
                if (EN(8) && unp > 0) {
                    pg8::Gemm g{XN, (const u16*)(args.ws + WS_WUP) + (size_t)l * DFF * DM, unp * 256, DFF, DM};
                    pg8::PanelSched S; S.so.init(unp * 256, DFF, G, cb); S.base = upb; S.latent_only = last; S.a_local = false; S.o_local = true; S.deal = deal; S.own = lsync; if (lsync && uR) S.so.wgm = 2;
                    pg8::EpiStore<2> E{(u16*)(args.ws + (uR ? WS_HIDR : hid_off)), DFF};
                    pg8::gemm_phase<pg8::EpiStore<2>, pg8::PanelSched, true, true>(lds, g, S, E);
                }
            }
            if (lsync) { if (!(last && s == 0) && PH(p0 + 6 + s) && PH(p0 + 7 + s)) xcd_local_barrier(bar, 32u); }
            else if (!(last && s == 0)) SEAM(p0 + 6 + s);
        }
        if (EN(10) && PH(p0 + 15)) {
            if (l == 0) tpass<2, true>(args, lds, tb, G, l, l + 1, 1, 0, true, 3, 0, 256, false, yb_off); else tpass<2>(args, lds, tb, G, l, last ? l : l + 1, 1, 0, !last, last ? 2 : 3, 0, 256, last, yb_off); }
        if (lsync && !last) { if (PH(p0 + 15) && PH(p0 + 16)) xcd_local_barrier(bar, 32u); } else SEAM(p0 + 15);
    }
#undef PH
#undef SEAM
}

#ifndef MK_PER_PHASE
#define MK_PER_PHASE 0
#endif
extern "C" void kernel_launch(void* const* d_in, const int* in_sizes, int n_in, void* d_out, int out_size, void* d_ws, size_t ws_size, hipStream_t stream) {
    static int grid = 0;
    if (grid == 0) {
        if (n_in != 28 || in_sizes[0] != NBATCH * SEQ * DM || out_size != NBATCH * SEQ * DM || ws_size < WS_END) {
            fprintf(stderr, "kernel_launch: unexpected shapes: n_in %d in0 %d out %d ws %zu (need >= %zu)\n", n_in, n_in > 0 ? in_sizes[0] : -1, out_size, ws_size, (size_t)WS_END); grid = -1; return; }
        int dev = 0, cus = 0, per_cu = 0;
        if (hipGetDevice(&dev) != hipSuccess || hipDeviceGetAttribute(&cus, hipDeviceAttributeMultiprocessorCount, dev) != hipSuccess) { grid = -1; return; }
        if (hipFuncSetAttribute((const void*)fwd_kernel, hipFuncAttributeMaxDynamicSharedMemorySize, LDS_BYTES) != hipSuccess) { fprintf(stderr, "kernel_launch: hipFuncSetAttribute failed\n"); grid = -1; return; }
        if (hipOccupancyMaxActiveBlocksPerMultiprocessor(&per_cu, (const void*)fwd_kernel, NWAVES * 64, LDS_BYTES) != hipSuccess || per_cu < 1)
            fprintf(stderr, "kernel_launch: note: occupancy query reports %d workgroups per CU\n", per_cu);
        (void)hipGetLastError();
        grid = cus;
    }
    if (grid < 0) return;
    if (hipMemsetAsync((char*)d_ws + WS_CTL, 0, CTL_ZERO_BYTES, stream) != hipSuccess) return;
    Args a{};
    for (int i = 0; i < 28; ++i) a.in[i] = d_in[i];
    a.out = (float*)d_out; a.ws = (unsigned char*)d_ws;
#if MK_PER_PHASE
    for (int p = 0; p < NPHASE; ++p) { a.ph_lo = p; a.ph_hi = p + 1; hipLaunchKernelGGL(fwd_kernel, dim3(grid), dim3(NWAVES * 64), LDS_BYTES, stream, a); }
#else
    a.ph_lo = 0; a.ph_hi = NPHASE;
    hipLaunchKernelGGL(fwd_kernel, dim3(grid), dim3(NWAVES * 64), LDS_BYTES, stream, a);
#endif
    const hipError_t le = hipPeekAtLastError();
    if (le != hipSuccess) fprintf(stderr, "kernel_launch: launch failed: %s\n", hipGetErrorName(le));
}
```
